# Optimizing an MI355X kernel written in HIP

```python
import math
import jax
import jax.numpy as jnp
from jax import lax
import numpy as np

D_MODEL = 1024
BATCH = 4
SEQ = 4096
DEPTH = 2

GRID_W = 64
CTX_LEN = 256
EPS = 1e-6

MLA_HEADS = 8
Q_LORA = 384
KV_LORA = 256
QK_NOPE = 64
QK_ROPE = 32
V_HEAD = 64
ROPE_BASE = 10000.0
Q_BLOCK = 128
SM_SCALE = (QK_NOPE + QK_ROPE) ** -0.5

LRU_WIDTH = 512
LRU_BLOCKS = 8
LRU_BLOCK = LRU_WIDTH // LRU_BLOCKS
LRU_CONV = 4
LRU_C = 8.0

HY_WIDTH = 512
HY_ORDER = 2
HY_SHORT = 3
HY_EMB = 33
HY_HID = 64
HY_INNER = 2
HY_FAST_DECAY = 0.3
HY_SLOW_DECAY = 1.5
HY_DECAY_TARGET = 1e-2

FFN_HID = ((8 * D_MODEL + 3 * 256 - 1) // (3 * 256)) * 256

N_BRANCH = 3
MLA_IN = Q_LORA + KV_LORA + QK_ROPE
IN_SPLITS = (MLA_IN, MLA_IN + LRU_WIDTH, MLA_IN + 2 * LRU_WIDTH, MLA_IN + 2 * LRU_WIDTH + 3 * HY_WIDTH)
IN_WIDTH = IN_SPLITS[-1] + N_BRANCH * D_MODEL

kernel_name = 'hybrid_mla_rglru_hyena_diffusion_trunk'

F32 = jnp.float32


def rmsnorm(x, g):
    xf = x.astype(F32)
    y = xf * lax.rsqrt(jnp.mean(xf * xf, axis=-1, keepdims=True) + EPS)
    return (y * g.astype(F32)).astype(x.dtype)


def modulate(h, shift, scale):
    return h * (1 + scale) + shift


def ada_mods(cond, w, b):
    m = (jax.nn.silu(cond) @ w + b)[..., None, :]
    return jnp.split(m, 6, axis=-1)


def short_conv(u, w, b):
    k = w.shape[0]
    left = k // 2
    y = lax.conv_general_dilated(u, w[:, None, :].astype(u.dtype), window_strides=(1,),
                                 padding=[(left, k - 1 - left)],
                                 dimension_numbers=('NWC', 'WIO', 'NWC'),
                                 feature_group_count=u.shape[-1])
    return y + b


def axial_rope(x):
    n = x.shape[1]
    rows = n // GRID_W
    row = jnp.repeat(jnp.arange(rows, dtype=F32), GRID_W)
    col = jnp.tile(jnp.arange(GRID_W, dtype=F32), rows)
    seg = QK_ROPE // 2
    inv = 1.0 / (ROPE_BASE ** (jnp.arange(seg // 2, dtype=F32) * 2.0 / seg))

    def rot(xs, pos):
        ang = pos[:, None] * inv
        cos = jnp.cos(ang)[:, None, :]
        sin = jnp.sin(ang)[:, None, :]
        x1, x2 = jnp.split(xs, 2, axis=-1)
        return jnp.concatenate([x1 * cos - x2 * sin, x1 * sin + x2 * cos], axis=-1)

    out = jnp.concatenate([rot(x[..., :seg], row), rot(x[..., seg:], col)], axis=-1)
    return out.astype(x.dtype)


def mla_qkv(z, q_g, w_uq, kv_g, w_ukv, with_pos):
    b, n, _ = z.shape
    cq, ckv, kpe = jnp.split(z, [Q_LORA, Q_LORA + KV_LORA], axis=-1)
    q = (rmsnorm(cq, q_g) @ w_uq).reshape(b, n, MLA_HEADS, QK_NOPE + QK_ROPE)
    kv = (rmsnorm(ckv, kv_g) @ w_ukv).reshape(b, n, MLA_HEADS, QK_NOPE + V_HEAD)
    q_nope, q_pe = jnp.split(q, [QK_NOPE], axis=-1)
    k_nope, v = jnp.split(kv, [QK_NOPE], axis=-1)
    k_pe = kpe[:, :, None, :]
    if with_pos:
        q_pe = axial_rope(q_pe)
        k_pe = axial_rope(k_pe)
    k_pe = jnp.broadcast_to(k_pe, (b, n, MLA_HEADS, QK_ROPE))
    q = jnp.concatenate([q_nope, q_pe], axis=-1)
    k = jnp.concatenate([k_nope, k_pe], axis=-1)
    return q, k, v


def softmax_attend(q, k, v):
    s = jnp.einsum('bqhd,bkhd->bhqk', q, k).astype(F32) * SM_SCALE
    p = jax.nn.softmax(s, axis=-1).astype(v.dtype)
    return jnp.einsum('bhqk,bkhd->bqhd', p, v)


def blocked_attend(q, k, v):
    b, n, h, d = q.shape
    nb = n // Q_BLOCK
    qb = jnp.moveaxis(q.reshape(b, nb, Q_BLOCK, h, d), 1, 0)
    o = lax.map(lambda blk: softmax_attend(blk, k, v), qb)
    return jnp.moveaxis(o, 0, 1).reshape(b, n, h * v.shape[-1])


def block_diag_linear(u, w, bias):
    b, n, c = u.shape
    y = jnp.einsum('bngi,gij->bngj', u.reshape(b, n, LRU_BLOCKS, LRU_BLOCK), w)
    return y.reshape(b, n, c) + bias


def rglru_coeffs(u, w_a, b_a, w_x, b_x, lam):
    r = jax.nn.sigmoid(block_diag_linear(u, w_a, b_a).astype(F32))
    i = jax.nn.sigmoid(block_diag_linear(u, w_x, b_x).astype(F32))
    log_a = -LRU_C * r * jax.nn.softplus(-lam.astype(F32))
    a = jnp.exp(log_a)
    gain = jnp.sqrt(-jnp.expm1(2.0 * log_a))
    return a, gain * (i * u.astype(F32))


def _affine_combine(first, second):
    a1, b1 = first
    a2, b2 = second
    return a1 * a2, a2 * b1 + b2


def scan_forward(a, b, h0):
    b = b.at[:, 0].add(a[:, 0] * h0)
    return lax.associative_scan(_affine_combine, (a, b), axis=1)[1]


def scan_backward(a, b, h0):
    return jnp.flip(scan_forward(jnp.flip(a, 1), jnp.flip(b, 1), h0), 1)


def hyena_filters(n, w1, b1, w2, b2, freq, w_out):
    t = jnp.linspace(0.0, 1.0, n, dtype=F32)[:, None]
    bands = (HY_EMB - 1) // 2
    w = 2.0 * math.pi * jnp.arange(n, dtype=F32) / n
    f = jnp.linspace(1e-4, bands - 1, bands, dtype=F32)
    ang = w[:, None] * f[None, :]
    z = jnp.concatenate([t, jnp.cos(ang), -jnp.sin(ang)], axis=-1)
    fr = freq.astype(F32)
    h = jnp.sin(fr * (z @ w1.astype(F32) + b1.astype(F32)))
    for j in range(HY_INNER):
        h = jnp.sin(fr * (h @ w2[j].astype(F32) + b2[j].astype(F32)))
    h = (h @ w_out.astype(F32)).reshape(n, 2, HY_ORDER, HY_WIDTH)
    max_decay = math.log(HY_DECAY_TARGET) / HY_FAST_DECAY
    min_decay = math.log(HY_DECAY_TARGET) / HY_SLOW_DECAY
    deltas = jnp.abs(jnp.linspace(min_decay, max_decay, HY_WIDTH, dtype=F32))
    return h * jnp.exp(-t * deltas)[:, None, None, :]


def bidir_long_conv(u, h_fwd, h_bwd, skip):
    n = u.shape[1]
    k = jnp.concatenate([h_fwd[:1] + h_bwd[:1], h_fwd[1:], jnp.zeros_like(h_fwd[:1]), h_bwd[:0:-1]], axis=0)
    kf = jnp.fft.rfft(k, axis=0)
    uf = jnp.fft.rfft(u.astype(F32), n=2 * n, axis=1)
    y = jnp.fft.irfft(uf * kf[None], n=2 * n, axis=1)[:, :n]
    return y + u.astype(F32) * skip.astype(F32)


def hyena_mix(z, conv_w, conv_b, filt, skip):
    z = short_conv(z, conv_w, conv_b)
    v, x1, x2 = jnp.split(z, 3, axis=-1)
    y = x1.astype(F32) * bidir_long_conv(v, filt[:, 0, 0], filt[:, 1, 0], skip[0])
    y = x2.astype(F32) * bidir_long_conv(y, filt[:, 0, 1], filt[:, 1, 1], skip[1])
    return y.astype(z.dtype)


def merge_branches(gate_logits, ya, yb, yc, p):
    g = jax.nn.sigmoid(gate_logits.astype(F32)).astype(ya.dtype)
    ga, gb, gc = jnp.split(g, N_BRANCH, axis=-1)
    y = ga * (ya @ p['w_br_a']) + gb * (yb @ p['w_br_b']) + gc * (yc @ p['w_br_c'])
    return y @ p['w_out']


def swiglu(h, p):
    return (jax.nn.silu(h @ p['ffn_w_gate']) * (h @ p['ffn_w_up'])) @ p['ffn_w_down']


def trunk_layer(x, xc, c, c_ctx, p, ctx_out):
    sh1, sc1, g1, sh2, sc2, g2 = ada_mods(c, p['ada_w'], p['ada_b'])
    csh1, csc1, cg1, csh2, csc2, cg2 = ada_mods(c_ctx, p['ada_w'], p['ada_b'])
    z_lat = modulate(rmsnorm(x, p['norm1_g']), sh1, sc1) @ p['w_in']
    z_ctx = modulate(rmsnorm(xc, p['norm1_g']), csh1, csc1) @ p['w_in']
    mla_l, lx_l, lg_l, hy_l, gt_l = jnp.split(z_lat, IN_SPLITS, axis=-1)
    mla_c, lx_c, lg_c, hy_c, gt_c = jnp.split(z_ctx, IN_SPLITS, axis=-1)

    qc, kc, vc = mla_qkv(mla_c, p['q_norm_g'], p['w_uq'], p['kv_norm_g'], p['w_ukv'], False)
    ql, kl, vl = mla_qkv(mla_l, p['q_norm_g'], p['w_uq'], p['kv_norm_g'], p['w_ukv'], True)
    ya_l = blocked_attend(ql, jnp.concatenate([kc, kl], axis=1), jnp.concatenate([vc, vl], axis=1))

    uc = short_conv(lx_c, p['lru_conv_w'], p['lru_conv_b'])
    ul = short_conv(lx_l, p['lru_conv_w'], p['lru_conv_b'])
    fwd = (p['lru_wa'][0], p['lru_ba'][0], p['lru_wx'][0], p['lru_bx'][0], p['lru_lam'][0])
    bwd = (p['lru_wa'][1], p['lru_ba'][1], p['lru_wx'][1], p['lru_bx'][1], p['lru_lam'][1])
    h0 = jnp.zeros((xc.shape[0], LRU_WIDTH), F32)
    hcf = scan_forward(*rglru_coeffs(uc, *fwd), h0)
    hcb = scan_backward(*rglru_coeffs(uc, *bwd), h0)
    hlf = scan_forward(*rglru_coeffs(ul, *fwd), hcf[:, -1])
    hlb = scan_backward(*rglru_coeffs(ul, *bwd), hcb[:, 0])
    yb_l = (hlf + hlb).astype(lg_l.dtype) * jax.nn.gelu(lg_l)

    filt_args = (p['hy_w1'], p['hy_b1'], p['hy_w2'], p['hy_b2'], p['hy_freq'], p['hy_w_out'])
    yc_l = hyena_mix(hy_l, p['hy_conv_w'], p['hy_conv_b'], hyena_filters(x.shape[1], *filt_args), p['hy_skip'])

    x = x + g1 * merge_branches(gt_l, ya_l, yb_l, yc_l, p)
    x = x + g2 * swiglu(modulate(rmsnorm(x, p['norm2_g']), sh2, sc2), p)

    if ctx_out:
        ya_c = softmax_attend(qc, kc, vc).reshape(xc.shape[0], xc.shape[1], MLA_HEADS * V_HEAD)
        yb_c = (hcf + hcb).astype(lg_c.dtype) * jax.nn.gelu(lg_c)
        yc_c = hyena_mix(hy_c, p['hy_conv_w'], p['hy_conv_b'], hyena_filters(xc.shape[1], *filt_args), p['hy_skip'])
        xc = xc + cg1 * merge_branches(gt_c, ya_c, yb_c, yc_c, p)
        xc = xc + cg2 * swiglu(modulate(rmsnorm(xc, p['norm2_g']), csh2, csc2), p)
    return x, xc


def setup_inputs(seed: int = 0) -> dict:
    key = jax.random.key(seed)
    keys = iter(jax.random.split(key, 48))
    L, D = DEPTH, D_MODEL

    def nrm(shape, scale):
        return jax.random.normal(next(keys), shape, F32) * scale

    def gain(shape):
        return 1.0 + nrm(shape, 0.02)

    a_c = jax.random.uniform(next(keys), (L, 2, LRU_WIDTH), F32, 0.9, 0.999)
    a = a_c ** (1.0 / LRU_C)
    lam = jnp.log(a) - jnp.log1p(-a)
    return {
        'x': nrm((BATCH, SEQ, D), 1.0),
        'c': nrm((BATCH, D), 1.0),
        'ctx': nrm((BATCH, CTX_LEN, D), 1.0),
        'c_ctx': nrm((D,), 1.0),
        'ada_w': nrm((L, D, 6 * D), 0.5 * D ** -0.5),
        'ada_b': nrm((L, 6 * D), 0.02),
        'norm1_g': gain((L, D)),
        'norm2_g': gain((L, D)),
        'w_in': nrm((L, D, IN_WIDTH), D ** -0.5),
        'q_norm_g': gain((L, Q_LORA)),
        'w_uq': nrm((L, Q_LORA, MLA_HEADS * (QK_NOPE + QK_ROPE)), Q_LORA ** -0.5),
        'kv_norm_g': gain((L, KV_LORA)),
        'w_ukv': nrm((L, KV_LORA, MLA_HEADS * (QK_NOPE + V_HEAD)), KV_LORA ** -0.5),
        'lru_conv_w': nrm((L, LRU_CONV, LRU_WIDTH), LRU_CONV ** -0.5),
        'lru_conv_b': nrm((L, LRU_WIDTH), 0.02),
        'lru_wa': nrm((L, 2, LRU_BLOCKS, LRU_BLOCK, LRU_BLOCK), LRU_BLOCK ** -0.5),
        'lru_ba': nrm((L, 2, LRU_WIDTH), 0.02),
        'lru_wx': nrm((L, 2, LRU_BLOCKS, LRU_BLOCK, LRU_BLOCK), LRU_BLOCK ** -0.5),
        'lru_bx': nrm((L, 2, LRU_WIDTH), 0.02),
        'lru_lam': lam,
        'hy_conv_w': nrm((L, HY_SHORT, 3 * HY_WIDTH), HY_SHORT ** -0.5),
        'hy_conv_b': nrm((L, 3 * HY_WIDTH), 0.02),
        'hy_w1': nrm((L, HY_EMB, HY_HID), HY_EMB ** -0.5),
        'hy_b1': nrm((L, HY_HID), 0.02),
        'hy_w2': nrm((L, HY_INNER, HY_HID, HY_HID), HY_HID ** -0.5),
        'hy_b2': nrm((L, HY_INNER, HY_HID), 0.02),
        'hy_freq': gain((L, HY_HID)),
        'hy_w_out': nrm((L, HY_HID, 2 * HY_ORDER * HY_WIDTH), 0.005),
        'hy_skip': nrm((L, HY_ORDER, HY_WIDTH), 0.3),
        'w_br_a': nrm((L, MLA_HEADS * V_HEAD, D), (MLA_HEADS * V_HEAD) ** -0.5),
        'w_br_b': nrm((L, LRU_WIDTH, D), LRU_WIDTH ** -0.5),
        'w_br_c': nrm((L, HY_WIDTH, D), HY_WIDTH ** -0.5),
        'w_out': nrm((L, D, D), D ** -0.5),
        'ffn_w_gate': nrm((L, D, FFN_HID), D ** -0.5),
        'ffn_w_up': nrm((L, D, FFN_HID), D ** -0.5),
        'ffn_w_down': nrm((L, FFN_HID, D), FFN_HID ** -0.5),
        'final_norm_g': gain((D,)),
    }


def reference(x, c, ctx, c_ctx, ada_w, ada_b, norm1_g, norm2_g, w_in, q_norm_g, w_uq, kv_norm_g, w_ukv,
              lru_conv_w, lru_conv_b, lru_wa, lru_ba, lru_wx, lru_bx, lru_lam,
              hy_conv_w, hy_conv_b, hy_w1, hy_b1, hy_w2, hy_b2, hy_freq, hy_w_out, hy_skip,
              w_br_a, w_br_b, w_br_c, w_out, ffn_w_gate, ffn_w_up, ffn_w_down, final_norm_g):
    xc = ctx
    for l in range(DEPTH):
        p = dict(ada_w=ada_w[l], ada_b=ada_b[l], norm1_g=norm1_g[l], norm2_g=norm2_g[l], w_in=w_in[l],
                 q_norm_g=q_norm_g[l], w_uq=w_uq[l], kv_norm_g=kv_norm_g[l], w_ukv=w_ukv[l],
                 lru_conv_w=lru_conv_w[l], lru_conv_b=lru_conv_b[l], lru_wa=lru_wa[l], lru_ba=lru_ba[l],
                 lru_wx=lru_wx[l], lru_bx=lru_bx[l], lru_lam=lru_lam[l],
                 hy_conv_w=hy_conv_w[l], hy_conv_b=hy_conv_b[l], hy_w1=hy_w1[l], hy_b1=hy_b1[l],
                 hy_w2=hy_w2[l], hy_b2=hy_b2[l], hy_freq=hy_freq[l], hy_w_out=hy_w_out[l], hy_skip=hy_skip[l],
                 w_br_a=w_br_a[l], w_br_b=w_br_b[l], w_br_c=w_br_c[l], w_out=w_out[l],
                 ffn_w_gate=ffn_w_gate[l], ffn_w_up=ffn_w_up[l], ffn_w_down=ffn_w_down[l])
        x, xc = trunk_layer(x, xc, c, c_ctx, p, l < DEPTH - 1)
    return rmsnorm(x, final_norm_g)
```

```cpp
#include <hip/hip_runtime.h>
#include <hip/hip_cooperative_groups.h>
#include <stdio.h>
namespace cg = cooperative_groups;

typedef unsigned short u16;
using bf16x8 = __attribute__((ext_vector_type(8))) short;
using f32x16 = __attribute__((ext_vector_type(16))) float;
using u32x4 = __attribute__((ext_vector_type(4))) unsigned;
using u32x2 = __attribute__((ext_vector_type(2))) unsigned;
using f32x2 = __attribute__((ext_vector_type(2))) float;
using f32x4 = __attribute__((ext_vector_type(4))) float;
static __device__ __forceinline__ u32x2 mk2(unsigned a, unsigned b) { u32x2 r; r.x = a; r.y = b; return r; }
static __device__ __forceinline__ f32x2 mkf2(float a, float b) { f32x2 r; r.x = a; r.y = b; return r; }
static __device__ __forceinline__ f32x4 mkf4(float a, float b, float c, float d) { f32x4 r; r.x = a; r.y = b; r.z = c; r.w = d; return r; }
#define DI __device__ __forceinline__
#define MFMA32(a, b, c) __builtin_amdgcn_mfma_f32_32x32x16_bf16((a), (b), (c), 0, 0, 0)

#define PANEL_W 4
#define REP_P0 1
#define REP_P1 1
#define REP_P2 1
#define REP_P3 1
#define REP_HY 1
#define REP_AT 1
#define REP_P5 1
#define REP_P6 1
#define REP_P7 1
#define REP_P8 1
#define REP_P9 1
#define REP_L3 1
#define REP_SY 1
constexpr int D = 1024, NB = 4, SEQ = 4096, CTX = 256;
constexpr int MLAT = NB * SEQ, MCTX = NB * CTX, MALL = MLAT + MCTX;
constexpr int INW = 6304, FFN = 2816, NKEY = CTX + SEQ;
constexpr float EPS = 1e-6f;

constexpr size_t SZ_H = (size_t)MALL * 1024 * 2;
constexpr size_t OFF_H = 0;
constexpr size_t OFF_ZMLA = OFF_H + SZ_H;
constexpr size_t OFF_ZLX = OFF_ZMLA + (size_t)MALL * 672 * 2;
constexpr size_t OFF_ZLG = OFF_ZLX + (size_t)MALL * 512 * 2;
constexpr size_t OFF_ZHY = OFF_ZLG + (size_t)MALL * 512 * 2;
constexpr size_t OFF_ZHC = OFF_ZHY + (size_t)NB * 1536 * 4096 * 2;
constexpr size_t OFF_Q = OFF_ZHC + (size_t)NB * 1536 * 256 * 2;
constexpr size_t OFF_K = OFF_Q + (size_t)MALL * 768 * 2;
constexpr size_t OFF_VT = OFF_K + (size_t)NB * 8 * NKEY * 96 * 2;
constexpr size_t OFF_W = OFF_VT + (size_t)NB * 8 * 64 * NKEY * 2;
constexpr size_t SZ_W = 19726336;
constexpr size_t OFF_XC = OFF_W + SZ_W;
constexpr size_t OFF_MODS = OFF_XC + (size_t)MCTX * 1024 * 4;
constexpr size_t OFF_HID = OFF_MODS + 2 * 5 * 6144 * 4;
constexpr size_t OFF_HID256 = OFF_HID + 2 * 4096 * 64 * 4;
constexpr size_t OFF_TW = OFF_HID256 + 256 * 64 * 4;
constexpr size_t OFF_AGG = OFF_TW + 8192 * 8;
constexpr size_t OFF_FILT = OFF_AGG + (size_t)4 * 68 * 2 * 512 * 8;
constexpr size_t OFF_BAR = OFF_FILT + (size_t)2048 * 4096 * 2;
constexpr size_t OFF_END = OFF_BAR + 16384;
constexpr size_t OFF_ACT = OFF_ZMLA;
constexpr size_t OFF_YCT = OFF_ZMLA;
constexpr size_t OFF_YC = OFF_ZHY;
constexpr size_t OFF_YM = OFF_K;
constexpr size_t W_INS = 0;
constexpr size_t W_ING = W_INS + 3328 * 1024;
constexpr size_t W_UQ = W_ING + 3072 * 1024;
constexpr size_t W_UKV = W_UQ + 768 * 384;
constexpr size_t W_BRA = W_UKV + 1024 * 256;
constexpr size_t W_BRB = W_BRA + 1024 * 512;
constexpr size_t W_BRC = W_BRB + 1024 * 512;
constexpr size_t W_OUT = W_BRC + 1024 * 512;
constexpr size_t W_LRU = W_OUT + 1024 * 1024;
constexpr size_t W_GU = 0;
constexpr size_t W_DN = W_GU + 5632 * 1024;

struct Params {
  const float *x, *c, *ctx, *c_ctx, *ada_w, *ada_b, *norm1_g, *norm2_g, *w_in, *q_norm_g, *w_uq, *kv_norm_g, *w_ukv,
      *lru_conv_w, *lru_conv_b, *lru_wa, *lru_ba, *lru_wx, *lru_bx, *lru_lam, *hy_conv_w, *hy_conv_b, *hy_w1, *hy_b1,
      *hy_w2, *hy_b2, *hy_freq, *hy_w_out, *hy_skip, *w_br_a, *w_br_b, *w_br_c, *w_out, *ffn_w_gate, *ffn_w_up,
      *ffn_w_down, *final_norm_g;
  float* out;
  char* ws;
};

typedef const Params __attribute__((address_space(4)))* KP;
static __device__ __forceinline__ KP lp(KP q) { asm volatile("" : "+s"(q)); return q; }
DI int tidx() { int t = __builtin_amdgcn_workitem_id_x(); asm volatile("" : "+v"(t)); return t; }
typedef __bf16 hwbf2 __attribute__((ext_vector_type(2)));
DI u16 f2bf(float x) { return __builtin_bit_cast(u16, (__bf16)x); }
DI float bf2f(u16 v) { return __uint_as_float(((unsigned)v) << 16); }
DI unsigned pack2(float lo, float hi) { f32x2 v; v.x = lo; v.y = hi; return __builtin_bit_cast(unsigned, __builtin_convertvector(v, hwbf2)); }
DI int crow(int r, int hh) { return (r & 3) + 8 * (r >> 2) + 4 * hh; }
DI float sigmoidf_(float x) { return __builtin_amdgcn_rcpf(1.f + __expf(-x)); }
DI float gelu_tanh(float x) {
  float u = 0.7978845608028654f * (x + 0.044715f * x * x * x);
  const float th = 1.f - 2.f * __builtin_amdgcn_rcpf(__expf(2.f * u) + 1.f);
  return 0.5f * x * (1.f + th);
}
DI float wave_sum(float v) {
#pragma unroll
  for (int o = 32; o > 0; o >>= 1) v += __shfl_xor(v, o);
  return v;
}
DI void zero_acc(f32x16& a) {
#pragma unroll
  for (int i = 0; i < 16; ++i) a[i] = 0.f;
}
DI void rowinfo(int row, int& b, int& t, int& isctx) {
  if (row < MLAT) { b = row >> 12; t = row & 4095; isctx = 0; }
  else { int rr = row - MLAT; b = rr >> 8; t = rr & 255; isctx = 1; }
}


#define XB_TMO      128
#define XB_XCNT(j)  (256  + 64 * (j))
#define XB_XSUB(j)  (1280 + 64 * (j))
#define XB_XGEN(j)  (2304 + 64 * (j))
#define XB_TOP      3328
#define XB_TOPGEN   3392
#define XCD_BAR_WORDS 3456
#define XB_SPIN_CAP (1u << 18)
#define LAS __attribute__((address_space(3)))
DI unsigned xb_ld(unsigned* p) { return __hip_atomic_load(p, __ATOMIC_RELAXED, __HIP_MEMORY_SCOPE_AGENT); }
DI unsigned xb_add(unsigned* p, unsigned v) { return __hip_atomic_fetch_add(p, v, __ATOMIC_RELAXED, __HIP_MEMORY_SCOPE_AGENT); }
DI unsigned xb_xcc_id() { return (unsigned)__builtin_amdgcn_s_getreg((3 << 11) | 20) & 0xFu; }
#define XB_SPIN(cond, bar) do { unsigned _sp = 0; while (cond) { __builtin_amdgcn_s_sleep(1); \
    if ((++_sp & 255u) == 0u) { if (xb_ld(&(bar)[XB_TMO])) break; if (_sp > XB_SPIN_CAP) { atomicAdd(&(bar)[XB_TMO], 1u); break; } } } } while (0)
struct XcdBarrier { unsigned* bar; unsigned x; volatile LAS unsigned* st; };
DI XcdBarrier xcd_barrier_post(unsigned* bar, volatile LAS unsigned* st) {
  XcdBarrier b; b.bar = bar; b.x = xb_xcc_id(); b.st = st;
  if (__builtin_amdgcn_workitem_id_x() == 0) (void)xb_add(&bar[XB_XCNT(b.x)], 1u);
  return b;
}
DI void xcd_barrier_complete(unsigned* bar, unsigned x, unsigned& nloc, unsigned& nx) {
  const unsigned G = gridDim.x * gridDim.y * gridDim.z;
  unsigned sum, cnt, mine, sp = 0u;
  for (;;) {
    sum = 0u; cnt = 0u; mine = 0u;
#pragma unroll
    for (unsigned j = 0; j < 16; ++j) { const unsigned c = xb_ld(&bar[XB_XCNT(j)]); sum += c; cnt += (c > 0u) ? 1u : 0u; mine = (j == x) ? c : mine; }
    if (sum == G) break;
    __builtin_amdgcn_s_sleep(1);
    if ((++sp & 255u) == 0u) { if (xb_ld(&bar[XB_TMO])) break; if (sp > XB_SPIN_CAP) { atomicAdd(&bar[XB_TMO], 1u); break; } }
  }
  nloc = mine > 0u ? mine : 1u; nx = cnt > 0u ? cnt : 1u;
}
DI void xcd_barrier(const XcdBarrier& b) {
  asm volatile("s_waitcnt vmcnt(0)" ::: "memory");
  __syncthreads();
  if (__builtin_amdgcn_workitem_id_x() == 0) {
    unsigned* bar = b.bar;
    __builtin_amdgcn_s_waitcnt(0);
    unsigned nloc = b.st[0], nx = b.st[1];
    if (nloc == 0u) { xcd_barrier_complete(bar, b.x, nloc, nx); b.st[0] = nloc; b.st[1] = nx; }
    const unsigned old = xb_add(&bar[XB_XSUB(b.x)], 1u);
    const unsigned gen = old / nloc;
    if (old + 1u == (gen + 1u) * nloc) {
      __builtin_amdgcn_fence(__ATOMIC_RELEASE, "agent");
      asm volatile("s_waitcnt vmcnt(0)" ::: "memory");
      const unsigned og = xb_add(&bar[XB_TOP], 1u);
      const unsigned tg = og / nx;
      if (og + 1u == (tg + 1u) * nx) xb_add(&bar[XB_TOPGEN], 1u);
      else XB_SPIN(xb_ld(&bar[XB_TOPGEN]) == tg, bar);
      __builtin_amdgcn_fence(__ATOMIC_ACQUIRE, "agent");
      xb_add(&bar[XB_XGEN(b.x)], 1u);
      asm volatile("s_waitcnt vmcnt(0)" ::: "memory");
    } else {
      XB_SPIN(xb_ld(&bar[XB_XGEN(b.x)]) == gen, bar);
      __builtin_amdgcn_fence(__ATOMIC_ACQUIRE, "agent");
      asm volatile("s_waitcnt vmcnt(0)" ::: "memory");
    }
  }
  __syncthreads();
}

template <int NT>
DI void gemm_main_np(f32x16 (&acc)[2][NT], const u16* __restrict__ A, int lda, int amode, const u16* __restrict__ Bt,
                  int ldb, int K, char* smem) {
  constexpr int LS = 72;
  constexpr int TILE = (128 + 64 * NT) * LS;
  u16* S = (u16*)smem;
  const int tid = tidx(), lane = tid & 63, w = tid >> 6, wm = w >> 1, wn = w & 1;
  const int l31 = lane & 31, hh = lane >> 5;
  const int lr = tid >> 3, lk = (tid & 7) * 8;
  u32x4 ra[4], rb[2 * NT];
#define GEMM_LOADG(kk) { const int ka_ = amode ? (((kk) >> 6) * 96) : (kk); \
    _Pragma("unroll") for (int i = 0; i < 4; ++i) ra[i] = *(const u32x4*)(A + (size_t)(lr + 32 * i) * lda + ka_ + lk); \
    _Pragma("unroll") for (int i = 0; i < 2 * NT; ++i) rb[i] = *(const u32x4*)(Bt + (size_t)(lr + 32 * i) * ldb + (kk) + lk); }
#define GEMM_STORES(buf) { u16* As_ = S + (buf) * TILE; u16* Bs_ = As_ + 128 * LS; \
    _Pragma("unroll") for (int i = 0; i < 4; ++i) *(u32x4*)(As_ + (lr + 32 * i) * LS + lk) = ra[i]; \
    _Pragma("unroll") for (int i = 0; i < 2 * NT; ++i) *(u32x4*)(Bs_ + (lr + 32 * i) * LS + lk) = rb[i]; }
  GEMM_LOADG(0)
  __syncthreads();
  GEMM_STORES(0)
  if (K > 64) GEMM_LOADG(64)
  __syncthreads();
  for (int k0 = 0; k0 < K; k0 += 64) {
    const int cur = (k0 >> 6) & 1;
    if (k0 + 64 < K) {
      GEMM_STORES(cur ^ 1)
      if (k0 + 128 < K) GEMM_LOADG(k0 + 128)
    }
    const u16* As = S + cur * TILE;
    const u16* Bs = As + 128 * LS;
#pragma unroll
    for (int s = 0; s < 4; ++s) {
      bf16x8 a[2], b[NT];
#pragma unroll
      for (int i = 0; i < 2; ++i) a[i] = *(const bf16x8*)(As + (wm * 64 + i * 32 + l31) * LS + s * 16 + hh * 8);
#pragma unroll
      for (int j = 0; j < NT; ++j) b[j] = *(const bf16x8*)(Bs + (wn * 32 * NT + j * 32 + l31) * LS + s * 16 + hh * 8);
#pragma unroll
      for (int i = 0; i < 2; ++i)
#pragma unroll
        for (int j = 0; j < NT; ++j) acc[i][j] = MFMA32(a[i], b[j], acc[i][j]);
    }
    __syncthreads();
  }
#undef GEMM_LOADG
#undef GEMM_STORES
}


#define SCHED_FENCE() asm volatile("" ::: "memory")
template <int NT>
DI void gemm_main(f32x16 (&acc)[2][NT], const u16* __restrict__ A, int lda, int amode, const u16* __restrict__ Bt,
                  int ldb, int K, char* smem) {
  constexpr int LS = 72;
  constexpr int TILE = (128 + 64 * NT) * LS;
  constexpr int NB2 = 2 * NT;
  u16* S = (u16*)smem;
  const int tid = tidx(), lane = tid & 63, w = tid >> 6, wm = w >> 1, wn = w & 1;
  const int l31 = lane & 31, hh = lane >> 5;
  const int lr = tid >> 3, lk = (tid & 7) * 8;
  u32x4 ra0[4], rb0[NB2], ra1[4], rb1[NB2];
#define G_LOAD(RA, RB, kk) { const int ka_ = amode ? (((kk) >> 6) * 96) : (kk); \
    _Pragma("unroll") for (int i = 0; i < 4; ++i) RA[i] = *(const u32x4*)(A + (size_t)(lr + 32 * i) * lda + ka_ + lk); \
    _Pragma("unroll") for (int i = 0; i < NB2; ++i) RB[i] = *(const u32x4*)(Bt + (size_t)(lr + 32 * i) * ldb + (kk) + lk); }
#define G_STORE_A(RA, buf, i) *(u32x4*)(S + (buf) * TILE + (lr + 32 * (i)) * LS + lk) = RA[i];
#define G_STORE_B(RB, buf, i) *(u32x4*)(S + (buf) * TILE + 128 * LS + (lr + 32 * (i)) * LS + lk) = RB[i];
#define G_STEP(RA, RB, cur, s, do_st) { \
    if (do_st) { G_STORE_A(RA, (cur) ^ 1, s) \
      _Pragma("unroll") for (int i = 0; i < NB2 / 4; ++i) G_STORE_B(RB, (cur) ^ 1, (s) * (NB2 / 4) + i) \
      if (NB2 < 4 && ((s) & 1) == 0) G_STORE_B(RB, (cur) ^ 1, (s) >> 1) } \
    SCHED_FENCE(); \
    const u16* As_ = S + (cur) * TILE; const u16* Bs_ = As_ + 128 * LS; \
    bf16x8 a_[2], b_[NT]; \
    _Pragma("unroll") for (int i = 0; i < 2; ++i) a_[i] = *(const bf16x8*)(As_ + (wm * 64 + i * 32 + l31) * LS + (s) * 16 + hh * 8); \
    _Pragma("unroll") for (int j = 0; j < NT; ++j) b_[j] = *(const bf16x8*)(Bs_ + (wn * 32 * NT + j * 32 + l31) * LS + (s) * 16 + hh * 8); \
    _Pragma("unroll") for (int i = 0; i < 2; ++i) _Pragma("unroll") for (int j = 0; j < NT; ++j) acc[i][j] = MFMA32(a_[i], b_[j], acc[i][j]); \
    SCHED_FENCE(); }
  const int nk = K >> 6;
  G_LOAD(ra0, rb0, 0)
  __syncthreads();
#pragma unroll
  for (int i = 0; i < 4; ++i) G_STORE_A(ra0, 0, i)
#pragma unroll
  for (int i = 0; i < NB2; ++i) G_STORE_B(rb0, 0, i)
  G_LOAD(ra0, rb0, 64)
  __syncthreads();
  for (int kt = 0; kt < nk; kt += 2) {
    const bool more2 = kt + 2 < nk;
    if (more2) G_LOAD(ra1, rb1, (kt + 2) * 64)
    G_STEP(ra0, rb0, 0, 0, true) G_STEP(ra0, rb0, 0, 1, true) G_STEP(ra0, rb0, 0, 2, true) G_STEP(ra0, rb0, 0, 3, true)
    __syncthreads();
    if (kt + 3 < nk) G_LOAD(ra0, rb0, (kt + 3) * 64)
    G_STEP(ra1, rb1, 1, 0, more2) G_STEP(ra1, rb1, 1, 1, more2) G_STEP(ra1, rb1, 1, 2, more2) G_STEP(ra1, rb1, 1, 3, more2)
    __syncthreads();
  }
#undef G_LOAD
#undef G_STORE_A
#undef G_STORE_B
#undef G_STEP
}

DI void gemm_wide(f32x16 (&acc)[2][4], const u16* __restrict__ A, int lda, const u16* __restrict__ Bt, int ldb, int K,
                  char* smem) {
  constexpr int LS = 72;
  u16* As = (u16*)smem;
  u16* Bs = As + 128 * LS;
  const int tid = tidx(), lane = tid & 63, w = tid >> 6, wm = w >> 1, wn = w & 1;
  const int l31 = lane & 31, hh = lane >> 5;
  const int lr = tid >> 3, lk = (tid & 7) * 8;
  u32x4 ra[4], rb[8];
#pragma unroll
  for (int i = 0; i < 4; ++i) ra[i] = *(const u32x4*)(A + (size_t)(lr + 32 * i) * lda + lk);
#pragma unroll
  for (int i = 0; i < 8; ++i) rb[i] = *(const u32x4*)(Bt + (size_t)(lr + 32 * i) * ldb + lk);
  for (int k0 = 0; k0 < K; k0 += 64) {
    __syncthreads();
#pragma unroll
    for (int i = 0; i < 4; ++i) *(u32x4*)(As + (lr + 32 * i) * LS + lk) = ra[i];
#pragma unroll
    for (int i = 0; i < 8; ++i) *(u32x4*)(Bs + (lr + 32 * i) * LS + lk) = rb[i];
    __syncthreads();
    if (k0 + 64 < K) {
      const int k1 = k0 + 64 + lk;
#pragma unroll
      for (int i = 0; i < 4; ++i) ra[i] = *(const u32x4*)(A + (size_t)(lr + 32 * i) * lda + k1);
#pragma unroll
      for (int i = 0; i < 8; ++i) rb[i] = *(const u32x4*)(Bt + (size_t)(lr + 32 * i) * ldb + k1);
    }
#pragma unroll
    for (int s = 0; s < 4; ++s) {
      bf16x8 a[2], b[4];
#pragma unroll
      for (int i = 0; i < 2; ++i) a[i] = *(const bf16x8*)(As + (wm * 64 + i * 32 + l31) * LS + s * 16 + hh * 8);
#pragma unroll
      for (int j = 0; j < 4; ++j) b[j] = *(const bf16x8*)(Bs + (wn * 128 + j * 32 + l31) * LS + s * 16 + hh * 8);
#pragma unroll
      for (int i = 0; i < 2; ++i)
#pragma unroll
        for (int j = 0; j < 4; ++j) acc[i][j] = MFMA32(a[i], b[j], acc[i][j]);
    }
  }
  __syncthreads();
}

DI void tile_map(int u, int MT, int NT, int& mt, int& nt, int PW = 8) {
  const int xcd = u & 7;
  int j = u >> 3;
  const int ML = MT >> 3;
  const int P = (NT + PW - 1) / PW, wlo = NT / P, rem = NT - wlo * P;
  int nstart = 0, width = wlo;
#pragma unroll 1
  for (int pn = 0; pn < P; ++pn) {
    width = wlo + (pn < rem ? 1 : 0);
    const int cnt = ML * width;
    if (j < cnt) break;
    j -= cnt; nstart += width;
  }
  const int mi = j / width;
  mt = mi * 8 + xcd;
  nt = nstart + (j - mi * width);
}

DI void p0_mods(KP p, int u, char* smem) {
  const int l = u / 192, n0 = (u % 192) * 32;
  float* ss = (float*)smem;
  float* red = ss + 5 * 1024;
  const int tid = tidx();
  __syncthreads();
  for (int i = tid; i < 5 * 1024; i += 256) {
    int ci = i >> 10, k = i & 1023;
    float v = (ci < 4) ? p->c[ci * 1024 + k] : p->c_ctx[k];
    ss[i] = v / (1.f + __expf(-v));
  }
  __syncthreads();
  const int kg = tid >> 5, cc = tid & 31;
  float a0 = 0, a1 = 0, a2 = 0, a3 = 0, a4 = 0;
  const float* wp = p->ada_w + (size_t)l * 1024 * 6144 + n0 + cc;
#pragma unroll 16
  for (int k = kg; k < 1024; k += 8) {
    float wv = wp[(size_t)k * 6144];
    a0 += ss[k] * wv; a1 += ss[1024 + k] * wv; a2 += ss[2048 + k] * wv; a3 += ss[3072 + k] * wv; a4 += ss[4096 + k] * wv;
  }
  red[(kg * 5 + 0) * 32 + cc] = a0; red[(kg * 5 + 1) * 32 + cc] = a1; red[(kg * 5 + 2) * 32 + cc] = a2;
  red[(kg * 5 + 3) * 32 + cc] = a3; red[(kg * 5 + 4) * 32 + cc] = a4;
  __syncthreads();
  if (tid < 160) {
    int ci = tid >> 5, c2 = tid & 31;
    float s = 0;
#pragma unroll
    for (int g = 0; g < 8; ++g) s += red[(g * 5 + ci) * 32 + c2];
    float* mods = (float*)(p->ws + OFF_MODS);
    mods[(l * 5 + ci) * 6144 + n0 + c2] = s + p->ada_b[l * 6144 + n0 + c2];
  }
}

DI void p0_tw(KP p, int u) {
  int k = u * 256 + tidx();
  float s, c;
  sincospif((float)k * (1.f / 4096.f), &s, &c);
  f32x2* tw = (f32x2*)(p->ws + OFF_TW);
  tw[k] = mkf2(c, -s);
}

DI void p0_hid(KP p, int u, char* smem) {
  const int tid = tidx(), lane = tid & 63, w = tid >> 6;
  const int gr = u * 4 + w;
  int l, n, t;
  float* dst;
  if (gr < 4096) { l = 0; n = 4096; t = gr; dst = (float*)(p->ws + OFF_HID) + (size_t)t * 64; }
  else if (gr < 8192) { l = 1; n = 4096; t = gr - 4096; dst = (float*)(p->ws + OFF_HID) + (size_t)(4096 + t) * 64; }
  else { l = 0; n = 256; t = gr - 8192; dst = (float*)(p->ws + OFF_HID256) + (size_t)t * 64; }
  float* zb = (float*)smem + w * 128;
  __syncthreads();
  if (lane < 33) {
    float v;
    if (lane == 0) v = (float)t / (float)(n - 1);
    else {
      int k = (lane - 1) & 15;
      float wt = (6.283185307179586f * (float)t) / (float)n;
      float f = 1e-4f + (float)k * ((15.f - 1e-4f) / 15.f);
      float ang = wt * f;
      v = (lane <= 16) ? cosf(ang) : -sinf(ang);
    }
    zb[lane] = v;
  }
  __syncthreads();
  const float fr = p->hy_freq[l * 64 + lane];
  float acc = p->hy_b1[l * 64 + lane];
#pragma unroll
  for (int i = 0; i < 33; ++i) acc += zb[i] * p->hy_w1[(l * 33 + i) * 64 + lane];
  float h = sinf(fr * acc);
  __syncthreads();
  zb[lane] = h;
  __syncthreads();
  for (int j2 = 0; j2 < 2; ++j2) {
    float a2 = p->hy_b2[(l * 2 + j2) * 64 + lane];
#pragma unroll
    for (int i = 0; i < 64; ++i) a2 += zb[i] * p->hy_w2[((l * 2 + j2) * 64 + i) * 64 + lane];
    h = sinf(fr * a2);
    __syncthreads();
    zb[lane] = h;
    __syncthreads();
  }
  dst[lane] = h;
}

enum { J_WINS = 0, J_WING, J_WUQ, J_WUKV, J_WBRA, J_WBRB, J_WBRC, J_WOUT, J_WGU, J_WDN };
DI float wsrc(KP p, int job, int l, int k, int n) {
  switch (job) {
    case J_WINS: {
      int c;
      if (n < 672) c = n; else if (n < 768) return 0.f; else c = n - 96;
      return p->w_in[((size_t)l * 1024 + k) * INW + c];
    }
    case J_WING: return p->w_in[((size_t)l * 1024 + k) * INW + 3232 + n];
    case J_WUQ: return p->w_uq[((size_t)l * 384 + k) * 768 + n] * p->q_norm_g[l * 384 + k];
    case J_WUKV: return p->w_ukv[((size_t)l * 256 + k) * 1024 + n] * p->kv_norm_g[l * 256 + k];
    case J_WBRA: return p->w_br_a[((size_t)l * 512 + k) * 1024 + n];
    case J_WBRB: return p->w_br_b[((size_t)l * 512 + k) * 1024 + n];
    case J_WBRC: return p->w_br_c[((size_t)l * 512 + k) * 1024 + n];
    case J_WOUT: return p->w_out[((size_t)l * 1024 + k) * 1024 + n];
    case J_WGU: {
      int T = n >> 7, wn = (n >> 6) & 1, j = (n >> 5) & 1, e = n & 31;
      int uu = T * 64 + wn * 32 + e;
      const float* s = j ? p->ffn_w_up : p->ffn_w_gate;
      return s[((size_t)l * 1024 + k) * FFN + uu];
    }
    default: return p->ffn_w_down[((size_t)l * FFN + k) * 1024 + n];
  }
}
DI void conv_tile(KP p, u16* dst, int K, int job, int l, int nt, int kt, char* smem) {
  float* tile = (float*)smem;
  const int tid = tidx();
  __syncthreads();
  {
    const int n = nt * 64 + (tid & 63), kb = kt * 64 + (tid >> 6) * 16;
#pragma unroll
    for (int i = 0; i < 16; ++i) tile[((tid >> 6) * 16 + i) * 65 + (tid & 63)] = wsrc(p, job, l, kb + i, n);
  }
  __syncthreads();
  {
    const int nl = tid >> 2, kq = (tid & 3) * 16;
    unsigned v[8];
#pragma unroll
    for (int j = 0; j < 8; ++j) v[j] = pack2(tile[(kq + 2 * j) * 65 + nl], tile[(kq + 2 * j + 1) * 65 + nl]);
    u16* d = dst + (size_t)(nt * 64 + nl) * K + kt * 64 + kq;
    *(u32x4*)d = u32x4{v[0], v[1], v[2], v[3]};
    *(u32x4*)(d + 8) = u32x4{v[4], v[5], v[6], v[7]};
  }
}
constexpr int CV1_TILES = 832 + 768 + 72 + 64 + 384 + 256;
constexpr int CV1_UNITS = CV1_TILES + 64;
DI void conv_stage1(KP p, int l, int u, char* smem) {
  u16* W = (u16*)(p->ws + OFF_W);
  if (u < 832) { conv_tile(p, W + W_INS, 1024, J_WINS, l, u >> 4, u & 15, smem); return; }
  u -= 832;
  if (u < 768) { conv_tile(p, W + W_ING, 1024, J_WING, l, u >> 4, u & 15, smem); return; }
  u -= 768;
  if (u < 72) { conv_tile(p, W + W_UQ, 384, J_WUQ, l, u / 6, u % 6, smem); return; }
  u -= 72;
  if (u < 64) { conv_tile(p, W + W_UKV, 256, J_WUKV, l, u >> 2, u & 3, smem); return; }
  u -= 64;
  if (u < 384) {
    int br = u >> 7, r = u & 127;
    conv_tile(p, W + W_BRA + (size_t)br * 1024 * 512, 512, J_WBRA + br, l, r >> 3, r & 7, smem);
    return;
  }
  u -= 384;
  if (u < 256) { conv_tile(p, W + W_OUT, 1024, J_WOUT, l, u >> 4, u & 15, smem); return; }
  u -= 256;
  for (int e = 0; e < 8; ++e) {
    int idx = (u * 8 + e) * 256 + tidx();
    int g = idx >> 14, n = (idx >> 6) & 255, i = idx & 63;
    int mat = n >> 6, j = n & 63, dir = mat >> 1;
    const float* src = (mat & 1) ? p->lru_wx : p->lru_wa;
    W[W_LRU + idx] = f2bf(src[((((size_t)l * 2 + dir) * 8 + g) * 64 + i) * 64 + j]);
  }
}
constexpr int CV2_UNITS = 1408 + 704;
DI void conv_stage2(KP p, int l, int u, char* smem) {
  u16* W = (u16*)(p->ws + OFF_W);
  if (u < 1408) { conv_tile(p, W + W_GU, 1024, J_WGU, l, u >> 4, u & 15, smem); return; }
  u -= 1408;
  conv_tile(p, W + W_DN, FFN, J_WDN, l, u / 44, u % 44, smem);
}


DI void filt_unit(KP p, int l, int u) {
  const int tb = u >> 6, cb = u & 63;
  const int t = tb * 256 + tidx();
  const float* hr = (const float*)(p->ws + OFF_HID) + ((size_t)l * 4096 + t) * 64;
  const float* wout = p->hy_w_out + (size_t)l * 64 * 2048 + cb * 32;
  float acc[32];
#pragma unroll
  for (int cc = 0; cc < 32; ++cc) acc[cc] = 0.f;
#pragma unroll 4
  for (int j4 = 0; j4 < 16; ++j4) {
    const f32x4 hv = *(const f32x4*)(hr + 4 * j4);
    const float* w0 = wout + (size_t)(4 * j4) * 2048;
#pragma unroll
    for (int cc = 0; cc < 32; ++cc)
      acc[cc] += hv.x * w0[cc] + hv.y * w0[2048 + cc] + hv.z * w0[4096 + cc] + hv.w * w0[6144 + cc];
  }
  const float mind = -4.605170185988091f / 1.5f, maxd = -4.605170185988091f / 0.3f;
  const float tl = (float)t / 4095.f;
  u16* F = (u16*)(p->ws + OFF_FILT);
#pragma unroll
  for (int cc = 0; cc < 32; ++cc) {
    const int col = cb * 32 + cc, c = col & 511;
    const float delta = fabsf(mind + (float)c * ((maxd - mind) / 511.f));
    F[(size_t)col * 4096 + t] = f2bf(acc[cc] * expf(-tl * delta));
  }
}

DI void norm_rows(KP p, int l, int which, int u, const float* xlat, const float* xctx) {
  const int lane = tidx() & 63, w = tidx() >> 6;
  const int row = u * 4 + w;
  int b, t, isctx;
  rowinfo(row, b, t, isctx);
  const float* xr = isctx ? (xctx + (size_t)(row - MLAT) * 1024) : (xlat + (size_t)row * 1024);
  const int ci = isctx ? 4 : b;
  const float* mods = (const float*)(p->ws + OFF_MODS) + (size_t)(l * 5 + ci) * 6144 + which * 3072;
  const float* g = (which ? p->norm2_g : p->norm1_g) + l * 1024;
  f32x4 v[4];
  float ss = 0;
#pragma unroll
  for (int j = 0; j < 4; ++j) {
    v[j] = *(const f32x4*)(xr + 4 * (lane + 64 * j));
    ss += v[j].x * v[j].x + v[j].y * v[j].y + v[j].z * v[j].z + v[j].w * v[j].w;
  }
  ss = wave_sum(ss);
  const float rstd = rsqrtf(ss * (1.f / 1024.f) + EPS);
  u16* H = (u16*)(p->ws + OFF_H) + (size_t)row * 1024;
#pragma unroll
  for (int j = 0; j < 4; ++j) {
    const int c0 = 4 * (lane + 64 * j);
    f32x4 gg = *(const f32x4*)(g + c0), sh = *(const f32x4*)(mods + c0), sc = *(const f32x4*)(mods + 1024 + c0);
    float o0 = v[j].x * rstd * gg.x * (1.f + sc.x) + sh.x;
    float o1 = v[j].y * rstd * gg.y * (1.f + sc.y) + sh.y;
    float o2 = v[j].z * rstd * gg.z * (1.f + sc.z) + sh.z;
    float o3 = v[j].w * rstd * gg.w * (1.f + sc.w) + sh.w;
    *(u32x2*)(H + c0) = mk2(pack2(o0, o1), pack2(o2, o3));
  }
}

DI void p2_inproj(KP p, int u, char* smem) {
  int mt, nt; tile_map(u, 136, 13, mt, nt, PANEL_W);
  const int lane = tidx() & 63, w = tidx() >> 6, wm = w >> 1, wn = w & 1, l31 = lane & 31, hh = lane >> 5;
  f32x16 acc[2][4];
#pragma unroll
  for (int i = 0; i < 2; ++i)
#pragma unroll
    for (int j = 0; j < 4; ++j) zero_acc(acc[i][j]);
  const u16* H = (const u16*)(p->ws + OFF_H);
  const u16* W = (const u16*)(p->ws + OFF_W) + W_INS;
  gemm_wide(acc, H + (size_t)mt * 128 * 1024, 1024, W + (size_t)nt * 256 * 1024, 1024, 1024, smem);
#pragma unroll
  for (int i = 0; i < 2; ++i)
#pragma unroll
    for (int j = 0; j < 4; ++j) {
      const int mrow0 = mt * 128 + wm * 64 + i * 32;
      const int n = nt * 256 + wn * 128 + j * 32 + l31;
      if (nt < 3) {
        if (n < 672) {
          u16* Z = (u16*)(p->ws + OFF_ZMLA);
#pragma unroll
          for (int r = 0; r < 16; ++r) Z[(size_t)(mrow0 + crow(r, hh)) * 672 + n] = f2bf(acc[i][j][r]);
        }
      } else if (nt < 7) {
        u16* Z = (u16*)(p->ws + (nt < 5 ? OFF_ZLX : OFF_ZLG));
        const int cc = n - (nt < 5 ? 768 : 1280);
#pragma unroll
        for (int r = 0; r < 16; ++r) Z[(size_t)(mrow0 + crow(r, hh)) * 512 + cc] = f2bf(acc[i][j][r]);
      } else {
        const int ch = n - 1792;
        u16* dst;
        if (mrow0 < MLAT) dst = (u16*)(p->ws + OFF_ZHY) + ((size_t)((mrow0 >> 12) * 1536 + ch)) * 4096 + (mrow0 & 4095);
        else { int rr = mrow0 - MLAT; dst = (u16*)(p->ws + OFF_ZHC) + ((size_t)((rr >> 8) * 1536 + ch)) * 256 + (rr & 255); }
#pragma unroll
        for (int q = 0; q < 4; ++q)
          *(u32x2*)(dst + 8 * q + 4 * hh) = mk2(pack2(acc[i][j][4 * q], acc[i][j][4 * q + 1]), pack2(acc[i][j][4 * q + 2], acc[i][j][4 * q + 3]));
      }
    }
}


DI void p2_inproj_half(KP p, int hu, char* smem) {
  int mt, ntw; tile_map(1536 + (hu >> 1), 136, 13, mt, ntw, PANEL_W);
  const int nt = ntw * 2 + (hu & 1);
  const int lane = tidx() & 63, w = tidx() >> 6, wm = w >> 1, wn = w & 1, l31 = lane & 31, hh = lane >> 5;
  f32x16 acc[2][2];
#pragma unroll
  for (int i = 0; i < 2; ++i)
#pragma unroll
    for (int j = 0; j < 2; ++j) zero_acc(acc[i][j]);
  const u16* H = (const u16*)(p->ws + OFF_H);
  const u16* W = (const u16*)(p->ws + OFF_W) + W_INS;
  gemm_main_np<2>(acc, H + (size_t)mt * 128 * 1024, 1024, 0, W + (size_t)nt * 128 * 1024, 1024, 1024, smem);
#pragma unroll
  for (int i = 0; i < 2; ++i)
#pragma unroll
    for (int j = 0; j < 2; ++j) {
      const int mrow0 = mt * 128 + wm * 64 + i * 32;
      const int n = nt * 128 + wn * 64 + j * 32 + l31;
      if (nt < 6) {
        if (n < 672) {
          u16* Z = (u16*)(p->ws + OFF_ZMLA);
#pragma unroll
          for (int r = 0; r < 16; ++r) Z[(size_t)(mrow0 + crow(r, hh)) * 672 + n] = f2bf(acc[i][j][r]);
        }
      } else if (nt < 14) {
        u16* Z = (u16*)(p->ws + (nt < 10 ? OFF_ZLX : OFF_ZLG));
        const int cc = n - (nt < 10 ? 768 : 1280);
#pragma unroll
        for (int r = 0; r < 16; ++r) Z[(size_t)(mrow0 + crow(r, hh)) * 512 + cc] = f2bf(acc[i][j][r]);
      } else {
        const int ch = n - 1792;
        u16* dst;
        if (mrow0 < MLAT) dst = (u16*)(p->ws + OFF_ZHY) + ((size_t)((mrow0 >> 12) * 1536 + ch)) * 4096 + (mrow0 & 4095);
        else { int rr = mrow0 - MLAT; dst = (u16*)(p->ws + OFF_ZHC) + ((size_t)((rr >> 8) * 1536 + ch)) * 256 + (rr & 255); }
#pragma unroll
        for (int q = 0; q < 4; ++q)
          *(u32x2*)(dst + 8 * q + 4 * hh) = mk2(pack2(acc[i][j][4 * q], acc[i][j][4 * q + 1]), pack2(acc[i][j][4 * q + 2], acc[i][j][4 * q + 3]));
      }
    }
}

DI void rope_consts(int e, int t, float& sn, float& cs) {
  const int i8 = e & 7;
  const float inv = __builtin_amdgcn_exp2f(-(float)i8 * 1.6609640474436813f);
  const float pos = (e < 16) ? (float)(t >> 6) : (float)(t & 63);
  const float rev = pos * inv * 0.15915494309189535f;
  sn = __builtin_amdgcn_sinf(rev);
  cs = __builtin_amdgcn_cosf(rev);
}
DI void row_rstd(const u16* Z, int row0, int col0, int ncol, float* rs) {
  const int tid = tidx(), rl = tid >> 1, half = tid & 1, per = ncol >> 1;
  const u16* src = Z + (size_t)(row0 + rl) * 672 + col0 + half * per;
  float s = 0;
  for (int i = 0; i < per; i += 8) {
    u32x4 v = *(const u32x4*)(src + i);
    unsigned vv[4] = {v.x, v.y, v.z, v.w};
#pragma unroll
    for (int q = 0; q < 4; ++q) {
      float a = __uint_as_float(vv[q] << 16), b = __uint_as_float(vv[q] & 0xffff0000u);
      s += a * a + b * b;
    }
  }
  s += __shfl_xor(s, 1);
  if (half == 0) rs[rl] = rsqrtf(s / (float)ncol + EPS);
}
DI void p3_qproj(KP p, int u, char* smem) {
  int mt, nt; tile_map(u, 136, 6, mt, nt);
  const int lane = tidx() & 63, w = tidx() >> 6, wm = w >> 1, wn = w & 1, l31 = lane & 31, hh = lane >> 5;
  float* rs = (float*)(smem + 73728);
  const u16* Z = (const u16*)(p->ws + OFF_ZMLA);
  __syncthreads();
  row_rstd(Z, mt * 128, 0, 384, rs);
  f32x16 acc[2][2];
#pragma unroll
  for (int i = 0; i < 2; ++i)
#pragma unroll
    for (int j = 0; j < 2; ++j) zero_acc(acc[i][j]);
  const u16* W = (const u16*)(p->ws + OFF_W) + W_UQ;
  gemm_main<2>(acc, Z + (size_t)mt * 128 * 672, 672, 0, W + (size_t)nt * 128 * 384, 384, 384, smem);
  u16* Q = (u16*)(p->ws + OFF_Q);
  const bool lat = (mt * 128) < MLAT;
#pragma unroll
  for (int i = 0; i < 2; ++i)
#pragma unroll
    for (int j = 0; j < 2; ++j) {
      const int ml0 = wm * 64 + i * 32;
      const int n0 = nt * 128 + wn * 64 + j * 32;
      const int e0 = n0 % 96;
      const bool rope = lat && (e0 == 64);
#pragma unroll
      for (int r = 0; r < 16; ++r) {
        const int ml = ml0 + crow(r, hh);
        const int row = mt * 128 + ml;
        float v = acc[i][j][r] * rs[ml];
        if (rope) {
          float sn, cs;
          rope_consts(l31, row & 4095, sn, cs);
          float pr = __shfl_xor(v, 8);
          v = (l31 & 8) ? (v * cs + pr * sn) : (v * cs - pr * sn);
        }
        Q[(size_t)row * 768 + n0 + l31] = f2bf(v);
      }
    }
}
DI void p3_kvproj(KP p, int u, char* smem) {
  int mt, nt; tile_map(u, 136, 8, mt, nt);
  const int lane = tidx() & 63, w = tidx() >> 6, wm = w >> 1, wn = w & 1, l31 = lane & 31, hh = lane >> 5;
  float* rs = (float*)(smem + 73728);
  const u16* Z = (const u16*)(p->ws + OFF_ZMLA);
  __syncthreads();
  row_rstd(Z, mt * 128, 384, 256, rs);
  f32x16 acc[2][2];
#pragma unroll
  for (int i = 0; i < 2; ++i)
#pragma unroll
    for (int j = 0; j < 2; ++j) zero_acc(acc[i][j]);
  const u16* W = (const u16*)(p->ws + OFF_W) + W_UKV;
  gemm_main<2>(acc, Z + (size_t)mt * 128 * 672 + 384, 672, 0, W + (size_t)nt * 128 * 256, 256, 256, smem);
  u16* Kb = (u16*)(p->ws + OFF_K);
  u16* Vt = (u16*)(p->ws + OFF_VT);
  int b, t0, isctx;
  rowinfo(mt * 128, b, t0, isctx);
  const int key_base = isctx ? t0 : (256 + t0);
#pragma unroll
  for (int i = 0; i < 2; ++i)
#pragma unroll
    for (int j = 0; j < 2; ++j) {
      const int ml0 = wm * 64 + i * 32;
      if (wn == 0) {
        const int e = j * 32 + l31;
#pragma unroll
        for (int r = 0; r < 16; ++r) {
          const int ml = ml0 + crow(r, hh);
          Kb[((size_t)(b * 8 + nt) * NKEY + key_base + ml) * 96 + e] = f2bf(acc[i][j][r] * rs[ml]);
        }
      } else {
        const int dv = j * 32 + l31;
        u16* dst = Vt + ((size_t)(b * 8 + nt) * 64 + dv) * NKEY + key_base + ml0;
#pragma unroll
        for (int q = 0; q < 4; ++q) {
          const int mlq = ml0 + 8 * q + 4 * hh;
          *(u32x2*)(dst + 8 * q + 4 * hh) =
              mk2(pack2(acc[i][j][4 * q] * rs[mlq], acc[i][j][4 * q + 1] * rs[mlq + 1]),
                         pack2(acc[i][j][4 * q + 2] * rs[mlq + 2], acc[i][j][4 * q + 3] * rs[mlq + 3]));
        }
      }
    }
}
DI void p3_kpe(KP p, int u) {
  const int row = u * 8 + (tidx() >> 5), e = tidx() & 31;
  const u16* Z = (const u16*)(p->ws + OFF_ZMLA) + (size_t)row * 672 + 640;
  float v = bf2f(Z[e]), pr = bf2f(Z[e ^ 8]);
  int b, t, isctx;
  rowinfo(row, b, t, isctx);
  if (!isctx) {
    float sn, cs;
    rope_consts(e, t, sn, cs);
    v = (e & 8) ? (v * cs + pr * sn) : (v * cs - pr * sn);
  }
  const int key = isctx ? t : 256 + t;
  u16* Kb = (u16*)(p->ws + OFF_K);
  const u16 o = f2bf(v);
#pragma unroll
  for (int hd = 0; hd < 8; ++hd) Kb[((size_t)(b * 8 + hd) * NKEY + key) * 96 + 64 + e] = o;
}

DI void lru_unit(KP p, int l, int u, int pass, char* smem, int dummy = 0) {
  const int b = u / 544, rem = u % 544, j = rem >> 3, g = rem & 7;
  const int tid = tidx(), lane = tid & 63, w = tid >> 6, l31 = lane & 31, hh = lane >> 5;
  u16* Au = (u16*)smem;
  float* uf = (float*)(smem + 9216);
  float* sa = (float*)(smem + 25856);
  float* sb = (float*)(smem + 42496);
  float* carry = (float*)(smem + 59136);
  int base, seglen, tpos0;
  if (j < 4) { base = MLAT + b * 256 + j * 64; seglen = 256; tpos0 = j * 64; }
  else { base = b * 4096 + (j - 4) * 64; seglen = 4096; tpos0 = (j - 4) * 64; }
  const u16* Zlx = (const u16*)(p->ws + OFF_ZLX);
  f32x2* agg = (f32x2*)(p->ws + OFF_AGG);
  __syncthreads();
  {
    const int c = tid & 63, tq = tid >> 6, cg = g * 64 + c;
    const float w0 = p->lru_conv_w[(l * 4 + 0) * 512 + cg], w1 = p->lru_conv_w[(l * 4 + 1) * 512 + cg];
    const float w2 = p->lru_conv_w[(l * 4 + 2) * 512 + cg], w3 = p->lru_conv_w[(l * 4 + 3) * 512 + cg];
    const float bias = p->lru_conv_b[l * 512 + cg];
    auto ld = [&](int tt) -> float {
      int tp = tpos0 + tt;
      return (tp >= 0 && tp < seglen) ? bf2f(Zlx[(size_t)(base + tt) * 512 + cg]) : 0.f;
    };
    const int t0 = tq * 16;
    float xv[19];
#pragma unroll
    for (int e = 0; e < 19; ++e) xv[e] = ld(t0 - 2 + e);
#pragma unroll
    for (int tt = 0; tt < 16; ++tt) {
      const float y = w0 * xv[tt] + w1 * xv[tt + 1] + w2 * xv[tt + 2] + w3 * xv[tt + 3] + bias;
      uf[(t0 + tt) * 65 + c] = y;
      Au[(t0 + tt) * 72 + c] = f2bf(y);
    }
  }
  if (pass == 3) {
    const int part = tid >> 7, dir = (tid >> 6) & 1, c = tid & 63, cg = g * 64 + c;
    const f32x2* ag = agg + ((size_t)(b * 68) * 2 + dir) * 512 + cg;
    f32x2 ab[34];
#pragma unroll
    for (int e = 0; e < 34; ++e) {
      const int sl = part * 34 + e;
      int ch; bool valid;
      if (dir == 0) { ch = sl; valid = sl < j; }
      else { ch = (sl < 4) ? (3 - sl) : (71 - sl); valid = (j < 4) ? (sl < 4 && ch > j) : (sl < 4 || ch > j); }
      ab[e] = valid ? ag[(size_t)ch * 1024] : mkf2(1.f, 0.f);
    }
    float A = 1.f, Bv = 0.f;
#pragma unroll
    for (int e = 0; e < 34; ++e) { A *= ab[e].x; Bv = ab[e].x * Bv + ab[e].y; }
    ((f32x2*)carry)[(part * 2 + dir) * 64 + c] = mkf2(A, Bv);
  }
  __syncthreads();
  const int th = w >> 1, chh = w & 1;
  f32x16 acc[4];
#pragma unroll
  for (int m = 0; m < 4; ++m) zero_acc(acc[m]);
  const u16* Wl = (const u16*)(p->ws + OFF_W) + W_LRU + (size_t)g * 256 * 64;
#pragma unroll
  for (int s = 0; s < 4; ++s) {
    bf16x8 a = *(const bf16x8*)(Au + (th * 32 + l31) * 72 + s * 16 + hh * 8);
#pragma unroll
    for (int m = 0; m < 4; ++m) {
      bf16x8 bb = *(const bf16x8*)(Wl + (size_t)(m * 64 + chh * 32 + l31) * 64 + s * 16 + hh * 8);
      acc[m] = MFMA32(a, bb, acc[m]);
    }
  }
  asm volatile("s_nop 15\n\ts_nop 15" ::: "memory");
  const int cl = chh * 32 + l31, cg = g * 64 + cl;
  float hsum[16];
#pragma unroll
  for (int dir = 0; dir < 2; ++dir) {
    const float ba = p->lru_ba[(l * 2 + dir) * 512 + cg], bx = p->lru_bx[(l * 2 + dir) * 512 + cg];
    const float lam = p->lru_lam[(l * 2 + dir) * 512 + cg];
    const float ex = __expf(-lam);
    const float sp = (ex < 0.03f) ? ex * (1.f - ex * (0.5f - ex * (0.33333334f - 0.25f * ex))) : __logf(1.f + ex);
#pragma unroll
    for (int r = 0; r < 16; ++r) {
      const int t = th * 32 + crow(r, hh);
      const float rg = sigmoidf_(acc[dir * 2][r] + ba), ig = sigmoidf_(acc[dir * 2 + 1][r] + bx);
      const float la = -8.f * rg * sp;
      const float a = __expf(la);
      const float z2 = 2.f * la;
      const float em = (z2 > -0.2f) ? -z2 * (1.f + z2 * (0.5f + z2 * (0.16666667f + z2 * (0.041666668f + z2 * 0.0083333338f)))) : 1.f - __expf(z2);
      const float gain = sqrtf(em);
      sa[cl * 65 + t] = a;
      sb[cl * 65 + t] = gain * ig * uf[t * 65 + cl];
    }
    __syncthreads();
    if (tid < 64) {
      const int c = tid;
      float h = 0.f, A = 1.f;
      if (pass == 3) { const f32x2 c0 = ((const f32x2*)carry)[(0 * 2 + dir) * 64 + c], c1 = ((const f32x2*)carry)[(1 * 2 + dir) * 64 + c]; h = c1.x * c0.y + c1.y; }
      if (dir == 0) {
#pragma unroll 8
        for (int t = 0; t < 64; ++t) { float a = sa[c * 65 + t]; h = a * h + sb[c * 65 + t]; A *= a; sb[c * 65 + t] = h; }
      } else {
#pragma unroll 8
        for (int t = 63; t >= 0; --t) { float a = sa[c * 65 + t]; h = a * h + sb[c * 65 + t]; A *= a; sb[c * 65 + t] = h; }
      }
      if (pass == 1) agg[((size_t)(b * 68 + j) * 2 + dir) * 512 + g * 64 + c] = mkf2(A, h);
    }
    __syncthreads();
    if (pass == 3) {
#pragma unroll
      for (int r = 0; r < 16; ++r) {
        const int t = th * 32 + crow(r, hh);
        float hv = sb[cl * 65 + t];
        hsum[r] = dir ? (hsum[r] + hv) : hv;
      }
    }
    __syncthreads();
  }
  if (pass == 3) {
    u16* Zlg = (u16*)(p->ws + OFF_ZLG);
#pragma unroll
    for (int r = 0; r < 16; ++r) {
      const int t = th * 32 + crow(r, hh);
      const size_t idx = (size_t)(base + t) * 512 + cg;
      const u16 ov = f2bf(hsum[r] * gelu_tanh(bf2f(Zlg[idx])));
      if (dummy) ((u16*)(p->ws + OFF_END))[(size_t)((base + t) & 2047) * 512 + cg] = ov; else Zlg[idx] = ov;
    }
  }
}

DI void attn_unit(KP p, int u, char* smem, int dummy = 0) {
  int b, hd, qrow0, nkt;
  if (u < 512) { b = u >> 7; hd = (u >> 4) & 7; qrow0 = b * 4096 + (u & 15) * 256; nkt = 68; }
  else { int uu = u - 512; b = uu >> 3; hd = uu & 7; qrow0 = MLAT + b * 256; nkt = 4; }
  const int tid = tidx(), lane = tid & 63, w = tid >> 6, l31 = lane & 31, hh = lane >> 5;
  u16* Ks = (u16*)smem;
  u16* Vs = Ks + 64 * 104;
  u16* Q = (u16*)(p->ws + OFF_Q);
  const u16* Kg = (const u16*)(p->ws + OFF_K) + (size_t)(b * 8 + hd) * NKEY * 96;
  const u16* Vg = (const u16*)(p->ws + OFF_VT) + (size_t)(b * 8 + hd) * 64 * NKEY;
  const int qrow = qrow0 + w * 64 + l31;
  bf16x8 qf[2][6];
#pragma unroll
  for (int g = 0; g < 2; ++g)
#pragma unroll
    for (int s = 0; s < 6; ++s) qf[g][s] = *(const bf16x8*)(Q + (size_t)(qrow + 32 * g) * 768 + hd * 96 + s * 16 + hh * 8);
  f32x16 O[2][2];
#pragma unroll
  for (int g = 0; g < 2; ++g) { zero_acc(O[g][0]); zero_acc(O[g][1]); }
  float mrun[2] = {-1e30f, -1e30f}, lsum[2] = {0.f, 0.f};
  const float scl = 0.10206207261596577f * 1.4426950408889634f;
  u32x4 rk[3], rv[2];
  auto loadt = [&](int kt) {
#pragma unroll
    for (int i = 0; i < 3; ++i) {
      int c = tid + 256 * i, key = c / 12, part = c % 12;
      rk[i] = *(const u32x4*)(Kg + (size_t)(kt * 64 + key) * 96 + part * 8);
    }
#pragma unroll
    for (int i = 0; i < 2; ++i) {
      int c = tid + 256 * i, dv = c >> 3, part = c & 7;
      rv[i] = *(const u32x4*)(Vg + (size_t)dv * NKEY + kt * 64 + part * 8);
    }
  };
  auto storet = [&](int buf) {
    u16* Kb = Ks + buf * 11008;
    u16* Vb = Kb + 64 * 104;
#pragma unroll
    for (int i = 0; i < 3; ++i) {
      int c = tid + 256 * i, key = c / 12, part = c % 12;
      *(u32x4*)(Kb + key * 104 + part * 8) = rk[i];
    }
#pragma unroll
    for (int i = 0; i < 2; ++i) {
      int c = tid + 256 * i, dv = c >> 3, part = c & 7;
      *(u32x2*)(Vb + dv * 68 + part * 8) = mk2(rv[i].x, rv[i].y);
      *(u32x2*)(Vb + dv * 68 + part * 8 + 4) = mk2(rv[i].z, rv[i].w);
    }
  };
  loadt(0);
  __syncthreads();
  storet(0);
  if (nkt > 1) loadt(1);
  __syncthreads();
  for (int kt = 0; kt < nkt; ++kt) {
    const int cur = kt & 1;
    if (kt + 1 < nkt) { storet(cur ^ 1); if (kt + 2 < nkt) loadt(kt + 2); }
    const u16* Kc = Ks + cur * 11008;
    const u16* Vc = Kc + 64 * 104;
    f32x16 S[2][2];
#pragma unroll
    for (int g = 0; g < 2; ++g) { zero_acc(S[g][0]); zero_acc(S[g][1]); }
#pragma unroll
    for (int mt = 0; mt < 2; ++mt)
#pragma unroll
      for (int s = 0; s < 6; ++s) {
        const bf16x8 a = *(const bf16x8*)(Kc + (mt * 32 + l31) * 104 + s * 16 + hh * 8);
        S[0][mt] = MFMA32(a, qf[0][s], S[0][mt]);
        S[1][mt] = MFMA32(a, qf[1][s], S[1][mt]);
      }
    asm volatile("s_nop 15\n\ts_nop 15" ::: "memory");
#pragma unroll
    for (int g = 0; g < 2; ++g) {
      float mx = -1e30f;
#pragma unroll
      for (int mt = 0; mt < 2; ++mt)
#pragma unroll
        for (int r = 0; r < 16; ++r) mx = fmaxf(mx, S[g][mt][r]);
      mx = fmaxf(mx, __shfl_xor(mx, 32)) * scl;
      const float mnew = fmaxf(mrun[g], mx);
      const float alpha = __builtin_amdgcn_exp2f(mrun[g] - mnew);
      mrun[g] = mnew;
      float ps = 0.f;
#pragma unroll
      for (int mt = 0; mt < 2; ++mt)
#pragma unroll
        for (int r = 0; r < 16; ++r) { float e = __builtin_amdgcn_exp2f(fmaf(S[g][mt][r], scl, -mnew)); S[g][mt][r] = e; ps += e; }
      lsum[g] = lsum[g] * alpha + ps;
      if (__builtin_amdgcn_ballot_w64(alpha != 1.f) != 0ull) {
#pragma unroll
        for (int d = 0; d < 2; ++d)
#pragma unroll
          for (int r = 0; r < 16; ++r) O[g][d][r] *= alpha;
      }
    }
#pragma unroll
    for (int mt = 0; mt < 2; ++mt)
#pragma unroll
      for (int s2 = 0; s2 < 2; ++s2) {
        bf16x8 pf[2];
#pragma unroll
        for (int g = 0; g < 2; ++g) {
          unsigned pk[4];
#pragma unroll
          for (int q = 0; q < 4; ++q) pk[q] = pack2(S[g][mt][8 * s2 + 2 * q], S[g][mt][8 * s2 + 2 * q + 1]);
          pf[g] = __builtin_bit_cast(bf16x8, (u32x4{pk[0], pk[1], pk[2], pk[3]}));
        }
#pragma unroll
        for (int d = 0; d < 2; ++d) {
          const u16* vp = Vc + (d * 32 + l31) * 68 + mt * 32 + s2 * 16 + 4 * hh;
          u32x2 lo = *(const u32x2*)vp, hi = *(const u32x2*)(vp + 8);
          const bf16x8 va = __builtin_bit_cast(bf16x8, (u32x4{lo.x, lo.y, hi.x, hi.y}));
          O[0][d] = MFMA32(va, pf[0], O[0][d]);
          O[1][d] = MFMA32(va, pf[1], O[1][d]);
        }
      }
    asm volatile("s_nop 15\n\ts_nop 15" ::: "memory");
    __syncthreads();
  }
#pragma unroll
  for (int g = 0; g < 2; ++g) {
    const float lt = lsum[g] + __shfl_xor(lsum[g], 32);
    const float inv = 1.f / lt;
    u16* dst = Q + (size_t)(qrow + 32 * g) * 768 + hd * 96;
    if (dummy) dst = (u16*)(p->ws + OFF_END) + (size_t)((qrow + 32 * g) & 1023) * 768 + hd * 96;
#pragma unroll
    for (int d = 0; d < 2; ++d)
#pragma unroll
      for (int q = 0; q < 4; ++q)
        *(u32x2*)(dst + d * 32 + 8 * q + 4 * hh) =
            mk2(pack2(O[g][d][4 * q] * inv, O[g][d][4 * q + 1] * inv), pack2(O[g][d][4 * q + 2] * inv, O[g][d][4 * q + 3] * inv));
  }
}

DI f32x2 cmul(f32x2 a, f32x2 b) { return mkf2(a.x * b.x - a.y * b.y, a.x * b.y + a.y * b.x); }
#define SW(x) ((x) ^ ((((x) >> 5) & 1) * 5) ^ ((((x) >> 6) & 1) * 26))
DI void fft8192(f32x2* buf, const f32x2* __restrict__ tw) {
  const int tid = tidx();
#pragma unroll 1
  for (int ls = 0; ls < 12; ls += 2) {
    const int s = 1 << ls;
    f32x2 a[8], b[8], c[8], d[8];
    __syncthreads();
#pragma unroll
    for (int e = 0; e < 8; ++e) {
      const int i = tid + 256 * e;
      const int pi = SW(i);
      a[e] = buf[pi]; b[e] = buf[pi + 2048]; c[e] = buf[pi + 4096]; d[e] = buf[pi + 6144];
    }
    __syncthreads();
#pragma unroll
    for (int e = 0; e < 8; ++e) {
      const int i = tid + 256 * e;
      const int q = i & (s - 1);
      const int ps = i - q;
      const float rev = (float)ps * (1.f / 8192.f);
      const f32x2 w1 = mkf2(__builtin_amdgcn_cosf(rev), -__builtin_amdgcn_sinf(rev));
      const f32x2 w2 = cmul(w1, w1), w3 = cmul(w1, w2);
      const f32x2 apc = mkf2(a[e].x + c[e].x, a[e].y + c[e].y), amc = mkf2(a[e].x - c[e].x, a[e].y - c[e].y);
      const f32x2 bpd = mkf2(b[e].x + d[e].x, b[e].y + d[e].y), bmd = mkf2(b[e].x - d[e].x, b[e].y - d[e].y);
      const int o = 4 * i - 3 * q;
      buf[SW(o)] = mkf2(apc.x + bpd.x, apc.y + bpd.y);
      buf[SW(o + s)] = cmul(w1, mkf2(amc.x + bmd.y, amc.y - bmd.x));
      buf[SW(o + 2 * s)] = cmul(w2, mkf2(apc.x - bpd.x, apc.y - bpd.y));
      buf[SW(o + 3 * s)] = cmul(w3, mkf2(amc.x - bmd.y, amc.y + bmd.x));
    }
  }
  {
    f32x2 a[16], b[16];
    __syncthreads();
#pragma unroll
    for (int e = 0; e < 16; ++e) { const int pi = SW(tid + 256 * e); a[e] = buf[pi]; b[e] = buf[pi + 4096]; }
    __syncthreads();
#pragma unroll
    for (int e = 0; e < 16; ++e) {
      const int pi = SW(tid + 256 * e);
      buf[pi] = mkf2(a[e].x + b[e].x, a[e].y + b[e].y);
      buf[pi + 4096] = mkf2(a[e].x - b[e].x, a[e].y - b[e].y);
    }
    __syncthreads();
  }
}
DI float sconv3(const u16* row, int t, int n, float w0, float w1, float w2, float bias) {
  float xm = (t > 0) ? bf2f(row[t - 1]) : 0.f, x0 = bf2f(row[t]), xp = (t + 1 < n) ? bf2f(row[t + 1]) : 0.f;
  return w0 * xm + w1 * x0 + w2 * xp + bias;
}
DI void hyena_unit(KP p, int l, int c, char* smem) {
  const int tid = tidx();
  f32x2* buf = (f32x2*)smem;
  const f32x2* tw = (const f32x2*)(p->ws + OFF_TW);
  const u16* Ff = (const u16*)(p->ws + OFF_FILT);
  const float* wout = p->hy_w_out + (size_t)l * 64 * 2048;
  const float mind = -4.605170185988091f / 1.5f, maxd = -4.605170185988091f / 0.3f;
  const float delta = fabsf(mind + (float)c * ((maxd - mind) / 511.f));
  u16* Zhy = (u16*)(p->ws + OFF_ZHY);
  u16* yct = (u16*)(p->ws + OFF_YCT);
  const float* cw = p->hy_conv_w + (size_t)l * 3 * 1536;
  const float* cb = p->hy_conv_b + (size_t)l * 1536;
  f32x2 KF[32];
#pragma unroll 1
  for (int o = 0; o < 2; ++o) {
    const int colf = o * 512 + c, colb = 1024 + o * 512 + c;
    const float skip = p->hy_skip[(l * 2 + o) * 512 + c];
    __syncthreads();
#pragma unroll 4
    for (int jj = 0; jj < 16; ++jj) {
      const int t = tid + 256 * jj;
      const float hf = bf2f(Ff[(size_t)colf * 4096 + t]), hb = bf2f(Ff[(size_t)colb * 4096 + t]);
      if (t == 0) { buf[SW(0)] = mkf2(hf + hb + skip, 0.f); buf[SW(4096)] = mkf2(0.f, 0.f); }
      else { buf[SW(t)] = mkf2(hf, 0.f); buf[SW(8192 - t)] = mkf2(hb, 0.f); }
    }
    fft8192(buf, tw);
#pragma unroll
    for (int j = 0; j < 32; ++j) KF[j] = buf[SW(tid + 256 * j)];
    const int gcol = (o == 0 ? 512 : 1024) + c;
    const float gw0 = cw[gcol], gw1 = cw[1536 + gcol], gw2 = cw[3072 + gcol], gb = cb[gcol];
    const float vw0 = cw[c], vw1 = cw[1536 + c], vw2 = cw[3072 + c], vb = cb[c];
#pragma unroll 1
    for (int pr = 0; pr < 2; ++pr) {
      const int b0 = 2 * pr, b1 = b0 + 1;
      u16* r0 = Zhy + (size_t)(b0 * 1536 + c) * 4096;
      u16* r1 = Zhy + (size_t)(b1 * 1536 + c) * 4096;
      u16* y0p = yct + (size_t)(b0 * 512 + c) * 4096;
      u16* y1p = yct + (size_t)(b1 * 512 + c) * 4096;
      __syncthreads();
#pragma unroll 4
      for (int jj = 0; jj < 16; ++jj) {
        const int t = tid + 256 * jj;
        float v0, v1;
        if (o == 0) { v0 = sconv3(r0, t, 4096, vw0, vw1, vw2, vb); v1 = sconv3(r1, t, 4096, vw0, vw1, vw2, vb); }
        else { v0 = bf2f(r0[t]); v1 = bf2f(r1[t]); }
        buf[SW(t)] = mkf2(v0, v1);
        buf[SW(t + 4096)] = mkf2(0.f, 0.f);
      }
      fft8192(buf, tw);
#pragma unroll
      for (int j = 0; j < 32; ++j) {
        const int f = tid + 256 * j;
        f32x2 z = cmul(buf[SW(f)], KF[j]);
        buf[SW(f)] = mkf2(z.x, -z.y);
      }
      fft8192(buf, tw);
      const u16* g0 = Zhy + (size_t)(b0 * 1536 + gcol) * 4096;
      const u16* g1 = Zhy + (size_t)(b1 * 1536 + gcol) * 4096;
#pragma unroll 4
      for (int jj = 0; jj < 16; ++jj) {
        const int t = tid + 256 * jj;
        const f32x2 r = buf[SW(t)];
        const float y0 = r.x * (1.f / 8192.f), y1 = -r.y * (1.f / 8192.f);
        const float x0 = sconv3(g0, t, 4096, gw0, gw1, gw2, gb), x1 = sconv3(g1, t, 4096, gw0, gw1, gw2, gb);
        if (o == 0) { r0[t] = f2bf(x0 * y0); r1[t] = f2bf(x1 * y1); }
        else { y0p[t] = f2bf(x0 * y0); y1p[t] = f2bf(x1 * y1); }
      }
    }
  }
  if (l == 0) {
    float* kk = (float*)smem;
    float* uu = kk + 512;
    const float* hid2 = (const float*)(p->ws + OFF_HID256);
    const u16* Zhc = (const u16*)(p->ws + OFF_ZHC);
    const int t = tid;
    float y1r[4];
#pragma unroll 1
    for (int o = 0; o < 2; ++o) {
      const int colf = o * 512 + c, colb = 1024 + o * 512 + c;
      const float skip = p->hy_skip[(l * 2 + o) * 512 + c];
      const int gcol = (o == 0 ? 512 : 1024) + c;
      const float gw0 = cw[gcol], gw1 = cw[1536 + gcol], gw2 = cw[3072 + gcol], gb = cb[gcol];
      const float vw0 = cw[c], vw1 = cw[1536 + c], vw2 = cw[3072 + c], vb = cb[c];
      __syncthreads();
      {
        float hf = 0.f, hb = 0.f;
        const f32x4* hr = (const f32x4*)(hid2 + t * 64);
#pragma unroll
        for (int j4 = 0; j4 < 16; ++j4) {
          const f32x4 hv = hr[j4];
          const float* wf = wout + (size_t)(4 * j4) * 2048;
          hf += hv.x * wf[colf] + hv.y * wf[2048 + colf] + hv.z * wf[4096 + colf] + hv.w * wf[6144 + colf];
          hb += hv.x * wf[colb] + hv.y * wf[2048 + colb] + hv.z * wf[4096 + colb] + hv.w * wf[6144 + colb];
        }
        const float dec = expf(-((float)t / 255.f) * delta);
        hf *= dec; hb *= dec;
        if (t == 0) kk[255] = hf + hb + skip;
        else { kk[255 + t] = hf; kk[255 - t] = hb; }
        if (t == 0) kk[511] = 0.f;
        f32x4 uv;
        if (o == 0) {
          uv.x = sconv3(Zhc + (size_t)(0 * 1536 + c) * 256, t, 256, vw0, vw1, vw2, vb);
          uv.y = sconv3(Zhc + (size_t)(1 * 1536 + c) * 256, t, 256, vw0, vw1, vw2, vb);
          uv.z = sconv3(Zhc + (size_t)(2 * 1536 + c) * 256, t, 256, vw0, vw1, vw2, vb);
          uv.w = sconv3(Zhc + (size_t)(3 * 1536 + c) * 256, t, 256, vw0, vw1, vw2, vb);
        } else uv = mkf4(y1r[0], y1r[1], y1r[2], y1r[3]);
        ((f32x4*)uu)[t] = uv;
      }
      __syncthreads();
      {
        f32x4 y = mkf4(0.f, 0.f, 0.f, 0.f);
#pragma unroll 8
        for (int s2 = 0; s2 < 256; ++s2) { const float kv = kk[255 + t - s2]; const f32x4 u4 = ((const f32x4*)uu)[s2]; y += kv * u4; }
        const f32x4 ut = ((const f32x4*)uu)[t];
        const float yy[4] = {y.x, y.y, y.z, y.w}, us[4] = {ut.x, ut.y, ut.z, ut.w};
#pragma unroll
        for (int b = 0; b < 4; ++b) {
          const float xg = sconv3(Zhc + (size_t)(b * 1536 + gcol) * 256, t, 256, gw0, gw1, gw2, gb);
          const float ov = xg * yy[b];
          if (o == 0) y1r[b] = ov;
          else yct[(size_t)NB * 512 * 4096 + (size_t)(b * 512 + c) * 256 + t] = f2bf(ov);
        }
      }
    }
  }
}


DI void yc_transpose_unit(KP p, int u, char* smem) {
  const int tid = tidx();
  const u16* src; u16* dst; int rowlen;
  int b, cb, tb;
  if (u < 2048) { b = u >> 9; cb = (u >> 6) & 7; tb = u & 63; rowlen = 4096;
    src = (const u16*)(p->ws + OFF_YCT) + (size_t)(b * 512 + cb * 64) * 4096 + tb * 64;
    dst = (u16*)(p->ws + OFF_YC) + (size_t)(b * 4096 + tb * 64) * 512 + cb * 64; }
  else { const int uu = u - 2048; b = uu >> 5; cb = (uu >> 2) & 7; tb = uu & 3; rowlen = 256;
    src = (const u16*)(p->ws + OFF_YCT) + (size_t)NB * 512 * 4096 + (size_t)(b * 512 + cb * 64) * 256 + tb * 64;
    dst = (u16*)(p->ws + OFF_YC) + (size_t)(MLAT + b * 256 + tb * 64) * 512 + cb * 64; }
  u16* tile = (u16*)smem;
  const int r = tid >> 2, q = tid & 3;
  __syncthreads();
  {
    const u32x4 v0 = *(const u32x4*)(src + (size_t)r * rowlen + q * 16);
    const u32x4 v1 = *(const u32x4*)(src + (size_t)r * rowlen + q * 16 + 8);
    unsigned* tp = (unsigned*)(tile + r * 66 + q * 16);
    tp[0] = v0.x; tp[1] = v0.y; tp[2] = v0.z; tp[3] = v0.w; tp[4] = v1.x; tp[5] = v1.y; tp[6] = v1.z; tp[7] = v1.w;
  }
  __syncthreads();
  {
    unsigned o[8];
#pragma unroll
    for (int e = 0; e < 8; ++e)
      o[e] = (unsigned)tile[(q * 16 + 2 * e) * 66 + r] | ((unsigned)tile[(q * 16 + 2 * e + 1) * 66 + r] << 16);
    u16* d = dst + (size_t)r * 512 + q * 16;
    *(u32x4*)d = u32x4{o[0], o[1], o[2], o[3]};
    *(u32x4*)(d + 8) = u32x4{o[4], o[5], o[6], o[7]};
  }
}

DI void p5_merge(KP p, int u, int mtiles, char* smem) {
  int mt, nt; tile_map(u, mtiles, 8, mt, nt);
  const int lane = tidx() & 63, w = tidx() >> 6, wm = w >> 1, wn = w & 1, l31 = lane & 31, hh = lane >> 5;
  const u16* W = (const u16*)(p->ws + OFF_W);
  const u16* H = (const u16*)(p->ws + OFF_H) + (size_t)mt * 128 * 1024;
  f32x16 out[2][2];
#pragma unroll
  for (int i = 0; i < 2; ++i)
#pragma unroll
    for (int j = 0; j < 2; ++j) zero_acc(out[i][j]);
#pragma unroll 1
  for (int br = 0; br < 3; ++br) {
    f32x16 acc[2][2];
#pragma unroll
    for (int i = 0; i < 2; ++i)
#pragma unroll
      for (int j = 0; j < 2; ++j) zero_acc(acc[i][j]);
    gemm_main_np<2>(acc, H, 1024, 0, W + W_ING + (size_t)(br * 1024 + nt * 128) * 1024, 1024, 1024, smem);
    unsigned gp[2][2][8];
#pragma unroll
    for (int i = 0; i < 2; ++i)
#pragma unroll
      for (int j = 0; j < 2; ++j)
#pragma unroll
        for (int q = 0; q < 8; ++q) {
          gp[i][j][q] = pack2(sigmoidf_(acc[i][j][2 * q]), sigmoidf_(acc[i][j][2 * q + 1]));
          acc[i][j][2 * q] = 0.f; acc[i][j][2 * q + 1] = 0.f;
        }
    const u16* A;
    int lda, amode = 0;
    if (br == 0) { A = (const u16*)(p->ws + OFF_Q) + (size_t)mt * 128 * 768; lda = 768; amode = 1; }
    else if (br == 1) { A = (const u16*)(p->ws + OFF_ZLG) + (size_t)mt * 128 * 512; lda = 512; }
    else { A = (const u16*)(p->ws + OFF_YC) + (size_t)mt * 128 * 512; lda = 512; }
    gemm_main_np<2>(acc, A, lda, amode, W + W_BRA + (size_t)br * 1024 * 512 + (size_t)nt * 128 * 512, 512, 512, smem);
#pragma unroll
    for (int i = 0; i < 2; ++i)
#pragma unroll
      for (int j = 0; j < 2; ++j)
#pragma unroll
        for (int q = 0; q < 8; ++q) {
          out[i][j][2 * q] += __uint_as_float(gp[i][j][q] << 16) * acc[i][j][2 * q];
          out[i][j][2 * q + 1] += __uint_as_float(gp[i][j][q] & 0xffff0000u) * acc[i][j][2 * q + 1];
        }
  }
  u16* YM = (u16*)(p->ws + OFF_YM);
#pragma unroll
  for (int i = 0; i < 2; ++i)
#pragma unroll
    for (int j = 0; j < 2; ++j) {
      const int mrow0 = mt * 128 + wm * 64 + i * 32, n = nt * 128 + wn * 64 + j * 32 + l31;
#pragma unroll
      for (int r = 0; r < 16; ++r) YM[(size_t)(mrow0 + crow(r, hh)) * 1024 + n] = f2bf(out[i][j][r]);
    }
}


DI void p5_merge_half(KP p, int u, int mt_off, char* smem) {
  const int mt = mt_off + (u >> 4), nt = u & 15;
  const int lane = tidx() & 63, w = tidx() >> 6, wm = w >> 1, wn = w & 1, l31 = lane & 31, hh = lane >> 5;
  const u16* W = (const u16*)(p->ws + OFF_W);
  const u16* H = (const u16*)(p->ws + OFF_H) + (size_t)mt * 128 * 1024;
  f32x16 out[2][1];
  zero_acc(out[0][0]); zero_acc(out[1][0]);
#pragma unroll 1
  for (int br = 0; br < 3; ++br) {
    f32x16 ag[2][1], ay[2][1];
    zero_acc(ag[0][0]); zero_acc(ag[1][0]); zero_acc(ay[0][0]); zero_acc(ay[1][0]);
    gemm_main_np<1>(ag, H, 1024, 0, W + W_ING + (size_t)(br * 1024 + nt * 64) * 1024, 1024, 1024, smem);
    const u16* A;
    int lda, amode = 0;
    if (br == 0) { A = (const u16*)(p->ws + OFF_Q) + (size_t)mt * 128 * 768; lda = 768; amode = 1; }
    else if (br == 1) { A = (const u16*)(p->ws + OFF_ZLG) + (size_t)mt * 128 * 512; lda = 512; }
    else { A = (const u16*)(p->ws + OFF_YC) + (size_t)mt * 128 * 512; lda = 512; }
    gemm_main_np<1>(ay, A, lda, amode, W + W_BRA + (size_t)br * 1024 * 512 + (size_t)nt * 64 * 512, 512, 512, smem);
#pragma unroll
    for (int i = 0; i < 2; ++i)
#pragma unroll
      for (int r = 0; r < 16; ++r) out[i][0][r] += sigmoidf_(ag[i][0][r]) * ay[i][0][r];
  }
  u16* YM = (u16*)(p->ws + OFF_YM);
#pragma unroll
  for (int i = 0; i < 2; ++i) {
    const int mrow0 = mt * 128 + wm * 64 + i * 32, n = nt * 64 + wn * 32 + l31;
#pragma unroll
    for (int r = 0; r < 16; ++r) YM[(size_t)(mrow0 + crow(r, hh)) * 1024 + n] = f2bf(out[i][0][r]);
  }
}

DI void resid_gemm(KP p, int l, int u, int mtiles, int which, const u16* A, int K, const u16* Wt, const float* xlat_in,
                   const float* xctx_in, float* xlat_out, float* xctx_out, char* smem, int dummy = 0, int mt_off = 0) {
  int mt, nt; tile_map(u, mtiles, 8, mt, nt); mt += mt_off;
  const int lane = tidx() & 63, w = tidx() >> 6, wm = w >> 1, wn = w & 1, l31 = lane & 31, hh = lane >> 5;
  f32x16 acc[2][2];
#pragma unroll
  for (int i = 0; i < 2; ++i)
#pragma unroll
    for (int j = 0; j < 2; ++j) zero_acc(acc[i][j]);
  gemm_main<2>(acc, A + (size_t)mt * 128 * K, K, 0, Wt + (size_t)nt * 128 * K, K, K, smem);
  int b, t0, isctx;
  rowinfo(mt * 128, b, t0, isctx);
  const float* gate = (const float*)(p->ws + OFF_MODS) + (size_t)(l * 5 + (isctx ? 4 : b)) * 6144 + which * 3072 + 2048;
#pragma unroll
  for (int i = 0; i < 2; ++i)
#pragma unroll
    for (int j = 0; j < 2; ++j) {
      const int mrow0 = mt * 128 + wm * 64 + i * 32, n = nt * 128 + wn * 64 + j * 32 + l31;
      const float gv = gate[n];
#pragma unroll
      for (int r = 0; r < 16; ++r) {
        const int row = mrow0 + crow(r, hh);
        if (dummy) ((float*)(p->ws + OFF_H))[(size_t)(row & 8191) * 1024 + n] = xlat_in[(size_t)(row & 8191) * 1024 + n] + gv * acc[i][j][r];
        else if (!isctx) xlat_out[(size_t)row * 1024 + n] = xlat_in[(size_t)row * 1024 + n] + gv * acc[i][j][r];
        else { size_t o = (size_t)(row - MLAT) * 1024 + n; xctx_out[o] = xctx_in[o] + gv * acc[i][j][r]; }
      }
    }
}


DI void resid_wide(KP p, int l, int u, int which, const u16* A, int K, const u16* Wt, const float* xin, float* xout, char* smem) {
  int mt, nt; tile_map(u, 128, 4, mt, nt);
  const int lane = tidx() & 63, w = tidx() >> 6, wm = w >> 1, wn = w & 1, l31 = lane & 31, hh = lane >> 5;
  f32x16 acc[2][4];
#pragma unroll
  for (int i = 0; i < 2; ++i)
#pragma unroll
    for (int j = 0; j < 4; ++j) zero_acc(acc[i][j]);
  gemm_wide(acc, A + (size_t)mt * 128 * K, K, Wt + (size_t)nt * 256 * K, K, K, smem);
  const int b = (mt * 128) >> 12;
  const float* gate = (const float*)(p->ws + OFF_MODS) + (size_t)(l * 5 + b) * 6144 + which * 3072 + 2048;
#pragma unroll
  for (int i = 0; i < 2; ++i)
#pragma unroll
    for (int j = 0; j < 4; ++j) {
      const int mrow0 = mt * 128 + wm * 64 + i * 32, n = nt * 256 + wn * 128 + j * 32 + l31;
      const float gv = gate[n];
#pragma unroll
      for (int r = 0; r < 16; ++r) {
        const size_t o = (size_t)(mrow0 + crow(r, hh)) * 1024 + n;
        xout[o] = xin[o] + gv * acc[i][j][r];
      }
    }
}


DI void resid_ctx_half(KP p, int l, int u, int which, const u16* A, int K, const u16* Wt, const float* xin, float* xout, char* smem) {
  const int mt = 128 + (u >> 4), nt = u & 15;
  const int lane = tidx() & 63, w = tidx() >> 6, wm = w >> 1, wn = w & 1, l31 = lane & 31, hh = lane >> 5;
  f32x16 acc[2][1];
  zero_acc(acc[0][0]); zero_acc(acc[1][0]);
  gemm_main_np<1>(acc, A + (size_t)mt * 128 * K, K, 0, Wt + (size_t)nt * 64 * K, K, K, smem);
  const float* gate = (const float*)(p->ws + OFF_MODS) + (size_t)(l * 5 + 4) * 6144 + which * 3072 + 2048;
#pragma unroll
  for (int i = 0; i < 2; ++i) {
    const int mrow0 = (mt - 128) * 128 + wm * 64 + i * 32, n = nt * 64 + wn * 32 + l31;
    const float gv = gate[n];
#pragma unroll
    for (int r = 0; r < 16; ++r) {
      const size_t o = (size_t)(mrow0 + crow(r, hh)) * 1024 + n;
      xout[o] = xin[o] + gv * acc[i][0][r];
    }
  }
}

DI void p8_ffn_gu(KP p, int u, int mtiles, char* smem) {
  int mt, nt; tile_map(u, mtiles, 22, mt, nt, PANEL_W);
  const int lane = tidx() & 63, w = tidx() >> 6, wm = w >> 1, wn = w & 1, l31 = lane & 31, hh = lane >> 5;
  f32x16 acc[2][4];
#pragma unroll
  for (int i = 0; i < 2; ++i)
#pragma unroll
    for (int j = 0; j < 4; ++j) zero_acc(acc[i][j]);
  const u16* H = (const u16*)(p->ws + OFF_H);
  const u16* W = (const u16*)(p->ws + OFF_W) + W_GU;
  gemm_wide(acc, H + (size_t)mt * 128 * 1024, 1024, W + (size_t)nt * 256 * 1024, 1024, 1024, smem);
  u16* act = (u16*)(p->ws + OFF_ACT);
#pragma unroll
  for (int i = 0; i < 2; ++i)
#pragma unroll
    for (int jp = 0; jp < 2; ++jp) {
      const int mrow0 = mt * 128 + wm * 64 + i * 32, uu = (nt * 2 + wn) * 64 + jp * 32 + l31;
#pragma unroll
      for (int r = 0; r < 16; ++r) {
        const float gt = acc[i][2 * jp][r], up = acc[i][2 * jp + 1][r];
        act[(size_t)(mrow0 + crow(r, hh)) * FFN + uu] = f2bf(gt * __builtin_amdgcn_rcpf(1.f + __expf(-gt)) * up);
      }
    }
}


DI void p8_ffn_gu_half(KP p, int hu, char* smem) {
  int mt, ntw; tile_map(2560 + (hu >> 1), 128, 22, mt, ntw, PANEL_W);
  const int nt = ntw * 2 + (hu & 1);
  const int lane = tidx() & 63, w = tidx() >> 6, wm = w >> 1, wn = w & 1, l31 = lane & 31, hh = lane >> 5;
  f32x16 acc[2][2];
#pragma unroll
  for (int i = 0; i < 2; ++i)
#pragma unroll
    for (int j = 0; j < 2; ++j) zero_acc(acc[i][j]);
  const u16* H = (const u16*)(p->ws + OFF_H);
  const u16* W = (const u16*)(p->ws + OFF_W) + W_GU;
  gemm_main_np<2>(acc, H + (size_t)mt * 128 * 1024, 1024, 0, W + (size_t)nt * 128 * 1024, 1024, 1024, smem);
  u16* act = (u16*)(p->ws + OFF_ACT);
#pragma unroll
  for (int i = 0; i < 2; ++i) {
    const int mrow0 = mt * 128 + wm * 64 + i * 32, uu = nt * 64 + wn * 32 + l31;
#pragma unroll
    for (int r = 0; r < 16; ++r) {
      const float gt = acc[i][0][r], up = acc[i][1][r];
      act[(size_t)(mrow0 + crow(r, hh)) * FFN + uu] = f2bf(gt * __builtin_amdgcn_rcpf(1.f + __expf(-gt)) * up);
    }
  }
}

DI void final_norm(KP p, int u) {
  const int lane = tidx() & 63, w = tidx() >> 6;
  const int row = u * 4 + w;
  float* xr = p->out + (size_t)row * 1024;
  f32x4 v[4];
  float ss = 0;
#pragma unroll
  for (int j = 0; j < 4; ++j) {
    v[j] = *(const f32x4*)(xr + 4 * (lane + 64 * j));
    ss += v[j].x * v[j].x + v[j].y * v[j].y + v[j].z * v[j].z + v[j].w * v[j].w;
  }
  ss = wave_sum(ss);
  const float rstd = rsqrtf(ss * (1.f / 1024.f) + EPS);
#pragma unroll
  for (int j = 0; j < 4; ++j) {
    const int c0 = 4 * (lane + 64 * j);
    f32x4 gg = *(const f32x4*)(p->final_norm_g + c0);
    *(f32x4*)(xr + c0) = mkf4(v[j].x * rstd * gg.x, v[j].y * rstd * gg.y, v[j].z * rstd * gg.z, v[j].w * rstd * gg.w);
  }
}

__global__ void __launch_bounds__(256, 2) trunk_megakernel(Params pk) {
#define XC ((float*)(lp(p)->ws + OFF_XC))
#define xlat_in (l ? (const float*)lp(p)->out : lp(p)->x)
#define xctx_in (l ? (const float*)XC : lp(p)->ctx)
#define mtiles (l ? 128 : 136)
#define mrows (mtiles * 128)
  const KP p = (KP)__builtin_amdgcn_kernarg_segment_ptr();
  __shared__ __attribute__((aligned(16))) char smem[74240];
  __shared__ u32x4 xb_words;
  if (tidx() == 0) xb_words = u32x4{0u, 0u, 0u, 0u};
  __syncthreads();
  (void)xcd_barrier_post((unsigned*)(p->ws + OFF_BAR), (volatile LAS unsigned*)&xb_words);
#define GBAR() { XcdBarrier xb_; xb_.bar = (unsigned*)(lp(p)->ws + OFF_BAR); xb_.x = xb_xcc_id(); xb_.st = (volatile LAS unsigned*)&xb_words; xcd_barrier(xb_); }
  const int G = gridDim.x, B = blockIdx.x;

  for (int rep = 0; rep < REP_P0; ++rep)
  for (int u = B; u < 384 + 2112; u += G) {
    if (u < 384) p0_mods(lp(p), u, smem);
    else p0_hid(lp(p), u - 384, smem);
  }
  GBAR();

#pragma unroll 1
  for (int l = 0; l < 2; ++l) {

    for (int rep = 0; rep < REP_P1; ++rep)
    for (int u = B; u < MALL / 4 + CV1_UNITS + 1024; u += G) {
      if (u < MALL / 4) norm_rows(lp(p), l, 0, u, xlat_in, xctx_in);
      else if (u < MALL / 4 + CV1_UNITS) conv_stage1(lp(p), l, u - MALL / 4, smem);
      else filt_unit(lp(p), l, u - MALL / 4 - CV1_UNITS);
    }
    GBAR();
    for (int rep = 0; rep < REP_P2; ++rep)
    for (int u = B; u < 1536 + 464; u += G) {
      if (u < 1536) p2_inproj(lp(p), u, smem);
      else p2_inproj_half(lp(p), u - 1536, smem);
    }
    GBAR();
    for (int rep = 0; rep < REP_P3; ++rep)
    for (int u = B; u < 816 + 1088 + 2176 + 2176; u += G) {
      if (u < 816) p3_qproj(lp(p), u, smem);
      else if (u < 1904) p3_kvproj(lp(p), u - 816, smem);
      else if (u < 4080) p3_kpe(lp(p), u - 1904);
      else lru_unit(lp(p), l, u - 4080, 1, smem);
    }
    GBAR();
    {
      const int nattn = l ? 512 : 544;
      for (int rep = 1; rep < REP_HY; ++rep)
        for (int u = B; u < 512; u += G) hyena_unit(lp(p), l, u, smem);
      for (int rep = 1; rep < REP_AT; ++rep)
        for (int u = B; u < nattn; u += G) attn_unit(lp(p), u, smem, 1);
      for (int u = B; u < 512; u += G) hyena_unit(lp(p), l, u, smem);
      for (int u = B; u < nattn; u += G) attn_unit(lp(p), u, smem);
    }
    GBAR();
    for (int rep = 0; rep < REP_L3; ++rep)
      for (int u = B; u < 2176 + (l ? 2048 : 2176); u += G) {
        if (u < 2176) { if (l == 0 || ((u % 544) >> 3) >= 4) lru_unit(lp(p), l, u, 3, smem, rep + 1 < REP_L3); }
        else yc_transpose_unit(lp(p), u - 2176, smem);
      }
    for (int rep = 1; rep < REP_SY; ++rep) GBAR();
    GBAR();
    for (int u = B; u < 1024 + (l ? 0 : 128); u += G) {
      if (u < 1024) p5_merge(lp(p), u, 128, smem);
      else p5_merge_half(lp(p), u - 1024, 128, smem);
    }
    GBAR();
    for (int u = B; u < 512 + (l ? 0 : 128); u += G) {
      if (u < 512) resid_wide(lp(p), l, u, 0, (const u16*)(p->ws + OFF_YM), 1024, (const u16*)(p->ws + OFF_W) + W_OUT, xlat_in, p->out, smem);
      else resid_ctx_half(lp(p), l, u - 512, 0, (const u16*)(p->ws + OFF_YM), 1024, (const u16*)(p->ws + OFF_W) + W_OUT, xctx_in, XC, smem);
    }
    GBAR();
    for (int rep = 0; rep < REP_P7; ++rep)
    for (int u = B; u < mrows / 4 + CV2_UNITS; u += G) {
      if (u < mrows / 4) norm_rows(lp(p), l, 1, u, p->out, XC);
      else conv_stage2(lp(p), l, u - mrows / 4, smem);
    }
    GBAR();
    if (l == 0) { for (int u = B; u < 136 * 22; u += G) p8_ffn_gu(lp(p), u, 136, smem); }
    else {
      for (int u = B; u < 2560 + 512; u += G) {
        if (u < 2560) p8_ffn_gu(lp(p), u, 128, smem);
        else p8_ffn_gu_half(lp(p), u - 2560, smem);
      }
    }
    GBAR();
    for (int u = B; u < 512 + (l ? 0 : 128); u += G) {
      if (u < 512) resid_wide(lp(p), l, u, 1, (const u16*)(p->ws + OFF_ACT), FFN, (const u16*)(p->ws + OFF_W) + W_DN, p->out, p->out, smem);
      else resid_ctx_half(lp(p), l, u - 512, 1, (const u16*)(p->ws + OFF_ACT), FFN, (const u16*)(p->ws + OFF_W) + W_DN, XC, XC, smem);
    }
    GBAR();
  }
  for (int u = B; u < MLAT / 4; u += G) final_norm(lp(p), u);
}
#undef XC
#undef xlat_in
#undef xctx_in
#undef mtiles
#undef mrows

extern "C" void kernel_launch(void* const* d_in, const int* in_sizes, int n_in, void* d_out, int out_size, void* d_ws,
                              size_t ws_size, hipStream_t stream) {
  static int grid_blocks = 0;
  if (!grid_blocks) {
    int dev = 0, cus = 0, per_cu = 0;
    hipGetDevice(&dev);
    hipDeviceGetAttribute(&cus, hipDeviceAttributeMultiprocessorCount, dev);
    hipOccupancyMaxActiveBlocksPerMultiprocessor(&per_cu, trunk_megakernel, 256, 0);
    if (per_cu > 2) per_cu = 2;
    if (per_cu < 1) per_cu = 1;
    grid_blocks = cus * per_cu;
  }
  Params p{};
  const float** pp = (const float**)&p;
  for (int i = 0; i < 37; ++i) pp[i] = (const float*)d_in[i];
  p.out = (float*)d_out;
  p.ws = (char*)d_ws;
  if (ws_size < OFF_END) fprintf(stderr, "workspace too small: %zu < %zu\n", ws_size, (size_t)OFF_END);
  hipMemsetAsync((char*)d_ws + OFF_BAR, 0, 16384, stream);
  void* args[] = {&p};
  hipError_t e = hipLaunchCooperativeKernel((void*)trunk_megakernel, dim3(grid_blocks), dim3(256), args, 0, stream);
  if (e != hipSuccess) fprintf(stderr, "cooperative launch failed: %s (grid %d)\n", hipGetErrorString(e), grid_blocks);
}
```

```cpp
#include <hip/hip_runtime.h>
#include <hip/hip_cooperative_groups.h>
#include <stdio.h>
namespace cg = cooperative_groups;

typedef unsigned short u16;
using bf16x8 = __attribute__((ext_vector_type(8))) short;
using f32x16 = __attribute__((ext_vector_type(16))) float;
using u32x4 = __attribute__((ext_vector_type(4))) unsigned;
using u32x2 = __attribute__((ext_vector_type(2))) unsigned;
using f32x2 = __attribute__((ext_vector_type(2))) float;
using f32x4 = __attribute__((ext_vector_type(4))) float;
static __device__ __forceinline__ u32x2 mk2(unsigned a, unsigned b) { u32x2 r; r.x = a; r.y = b; return r; }
static __device__ __forceinline__ f32x2 mkf2(float a, float b) { f32x2 r; r.x = a; r.y = b; return r; }
static __device__ __forceinline__ f32x4 mkf4(float a, float b, float c, float d) { f32x4 r; r.x = a; r.y = b; r.z = c; r.w = d; return r; }
#define DI __device__ __forceinline__
#define MFMA32(a, b, c) __builtin_amdgcn_mfma_f32_32x32x16_bf16((a), (b), (c), 0, 0, 0)

#define PANEL_W 4
#define REP_P0 1
#define REP_P1 1
#define REP_P2 1
#define REP_P3 1
#define REP_HY 1
#define REP_AT 1
#define REP_P5 1
#define REP_P6 1
#define REP_P7 1
#define REP_P8 1
#define REP_P9 1
#define REP_L3 1
#define REP_SY 1
constexpr int D = 1024, NB = 4, SEQ = 4096, CTX = 256;
constexpr int MLAT = NB * SEQ, MCTX = NB * CTX, MALL = MLAT + MCTX;
constexpr int INW = 6304, FFN = 2816, NKEY = CTX + SEQ;
constexpr float EPS = 1e-6f;

constexpr size_t SZ_H = (size_t)MALL * 1024 * 2;
constexpr size_t OFF_H = 0;
constexpr size_t OFF_ZMLA = OFF_H + SZ_H;
constexpr size_t OFF_ZLX = OFF_ZMLA + (size_t)MALL * 672 * 2;
constexpr size_t OFF_ZLG = OFF_ZLX + (size_t)MALL * 512 * 2;
constexpr size_t OFF_ZHY = OFF_ZLG + (size_t)MALL * 512 * 2;
constexpr size_t OFF_ZHC = OFF_ZHY + (size_t)NB * 1536 * 4096 * 2;
constexpr size_t OFF_Q = OFF_ZHC + (size_t)NB * 1536 * 256 * 2;
constexpr size_t OFF_K = OFF_Q + (size_t)MALL * 768 * 2;
constexpr size_t OFF_VT = OFF_K + (size_t)NB * 8 * NKEY * 96 * 2;
constexpr size_t OFF_W = OFF_VT + (size_t)NB * 8 * 64 * NKEY * 2;
constexpr size_t SZ_W = 19726336;
constexpr size_t OFF_XC = OFF_W + SZ_W;
constexpr size_t OFF_MODS = OFF_XC + (size_t)MCTX * 1024 * 4;
constexpr size_t OFF_HID = OFF_MODS + 2 * 5 * 6144 * 4;
constexpr size_t OFF_HID256 = OFF_HID + 2 * 4096 * 64 * 4;
constexpr size_t OFF_TW = OFF_HID256 + 256 * 64 * 4;
constexpr size_t OFF_AGG = OFF_TW + 8192 * 8;
constexpr size_t OFF_FILT = OFF_AGG + (size_t)4 * 68 * 2 * 512 * 8;
constexpr size_t OFF_BAR = OFF_FILT + (size_t)2048 * 4096 * 2;
constexpr size_t OFF_END = OFF_BAR + 16384;
constexpr size_t OFF_ACT = OFF_ZMLA;
constexpr size_t OFF_YCT = OFF_ZMLA;
constexpr size_t OFF_YC = OFF_ZHY;
constexpr size_t OFF_YM = OFF_K;
constexpr size_t W_INS = 0;
constexpr size_t W_ING = W_INS + 3328 * 1024;
constexpr size_t W_UQ = W_ING + 3072 * 1024;
constexpr size_t W_UKV = W_UQ + 768 * 384;
constexpr size_t W_BRA = W_UKV + 1024 * 256;
constexpr size_t W_BRB = W_BRA + 1024 * 512;
constexpr size_t W_BRC = W_BRB + 1024 * 512;
constexpr size_t W_OUT = W_BRC + 1024 * 512;
constexpr size_t W_LRU = W_OUT + 1024 * 1024;
constexpr size_t W_GU = 0;
constexpr size_t W_DN = W_GU + 5632 * 1024;

struct Params {
  const float *x, *c, *ctx, *c_ctx, *ada_w, *ada_b, *norm1_g, *norm2_g, *w_in, *q_norm_g, *w_uq, *kv_norm_g, *w_ukv,
      *lru_conv_w, *lru_conv_b, *lru_wa, *lru_ba, *lru_wx, *lru_bx, *lru_lam, *hy_conv_w, *hy_conv_b, *hy_w1, *hy_b1,
      *hy_w2, *hy_b2, *hy_freq, *hy_w_out, *hy_skip, *w_br_a, *w_br_b, *w_br_c, *w_out, *ffn_w_gate, *ffn_w_up,
      *ffn_w_down, *final_norm_g;
  float* out;
  char* ws;
};

typedef const Params __attribute__((address_space(4)))* KP;
static __device__ __forceinline__ KP lp(KP q) { asm volatile("" : "+s"(q)); return q; }
DI int tidx() { int t = __builtin_amdgcn_workitem_id_x(); asm volatile("" : "+v"(t)); return t; }
typedef __bf16 hwbf2 __attribute__((ext_vector_type(2)));
DI u16 f2bf(float x) { return __builtin_bit_cast(u16, (__bf16)x); }
DI float bf2f(u16 v) { return __uint_as_float(((unsigned)v) << 16); }
DI unsigned pack2(float lo, float hi) { f32x2 v; v.x = lo; v.y = hi; return __builtin_bit_cast(unsigned, __builtin_convertvector(v, hwbf2)); }
DI int crow(int r, int hh) { return (r & 3) + 8 * (r >> 2) + 4 * hh; }
DI float sigmoidf_(float x) { return __builtin_amdgcn_rcpf(1.f + __expf(-x)); }
DI float gelu_tanh(float x) {
  float u = 0.7978845608028654f * (x + 0.044715f * x * x * x);
  const float th = 1.f - 2.f * __builtin_amdgcn_rcpf(__expf(2.f * u) + 1.f);
  return 0.5f * x * (1.f + th);
}
DI float wave_sum(float v) {
#pragma unroll
  for (int o = 32; o > 0; o >>= 1) v += __shfl_xor(v, o);
  return v;
}
DI void zero_acc(f32x16& a) {
#pragma unroll
  for (int i = 0; i < 16; ++i) a[i] = 0.f;
}
DI void rowinfo(int row, int& b, int& t, int& isctx) {
  if (row < MLAT) { b = row >> 12; t = row & 4095; isctx = 0; }
  else { int rr = row - MLAT; b = rr >> 8; t = rr & 255; isctx = 1; }
}


DI void store_tile_bf16(u16* base, size_t ld, const f32x16& v, int l31, int hh) {
  const int o = l31 & 1;
  const unsigned m = 0u - (unsigned)o;
  u16* ptr = base + (size_t)(4 * hh + o) * ld + (l31 & ~1);
#pragma unroll
  for (int k = 0; k < 8; ++k) {
    const unsigned a = __float_as_uint(v[2 * k]), bq = __float_as_uint(v[2 * k + 1]);
    const unsigned keep = (a & ~m) | (bq & m);
    const unsigned send = (bq & ~m) | (a & m);
    const unsigned recv = (unsigned)__builtin_amdgcn_mov_dpp((int)send, 0xB1, 0xF, 0xF, true);
    const unsigned lo = (keep & ~m) | (recv & m), hi = (recv & ~m) | (keep & m);
    *(unsigned*)(ptr + (size_t)((2 * k & 3) + 8 * (2 * k >> 2)) * ld) = pack2(__uint_as_float(lo), __uint_as_float(hi));
  }
}

#define XB_TMO      128
#define XB_XCNT(j)  (256  + 64 * (j))
#define XB_XSUB(j)  (1280 + 64 * (j))
#define XB_XGEN(j)  (2304 + 64 * (j))
#define XB_TOP      3328
#define XB_TOPGEN   3392
#define XCD_BAR_WORDS 3456
#define XB_SPIN_CAP (1u << 18)
#define LAS __attribute__((address_space(3)))
DI unsigned xb_ld(unsigned* p) { return __hip_atomic_load(p, __ATOMIC_RELAXED, __HIP_MEMORY_SCOPE_AGENT); }
DI unsigned xb_add(unsigned* p, unsigned v) { return __hip_atomic_fetch_add(p, v, __ATOMIC_RELAXED, __HIP_MEMORY_SCOPE_AGENT); }
DI unsigned xb_xcc_id() { return (unsigned)__builtin_amdgcn_s_getreg((3 << 11) | 20) & 0xFu; }
#define XB_SPIN(cond, bar) do { unsigned _sp = 0; while (cond) { __builtin_amdgcn_s_sleep(1); \
    if ((++_sp & 255u) == 0u) { if (xb_ld(&(bar)[XB_TMO])) break; if (_sp > XB_SPIN_CAP) { atomicAdd(&(bar)[XB_TMO], 1u); break; } } } } while (0)
struct XcdBarrier { unsigned* bar; unsigned x; volatile LAS unsigned* st; };
DI XcdBarrier xcd_barrier_post(unsigned* bar, volatile LAS unsigned* st) {
  XcdBarrier b; b.bar = bar; b.x = xb_xcc_id(); b.st = st;
  if (__builtin_amdgcn_workitem_id_x() == 0) (void)xb_add(&bar[XB_XCNT(b.x)], 1u);
  return b;
}
DI void xcd_barrier_complete(unsigned* bar, unsigned x, unsigned& nloc, unsigned& nx) {
  const unsigned G = gridDim.x * gridDim.y * gridDim.z;
  unsigned sum, cnt, mine, sp = 0u;
  for (;;) {
    sum = 0u; cnt = 0u; mine = 0u;
#pragma unroll
    for (unsigned j = 0; j < 16; ++j) { const unsigned c = xb_ld(&bar[XB_XCNT(j)]); sum += c; cnt += (c > 0u) ? 1u : 0u; mine = (j == x) ? c : mine; }
    if (sum == G) break;
    __builtin_amdgcn_s_sleep(1);
    if ((++sp & 255u) == 0u) { if (xb_ld(&bar[XB_TMO])) break; if (sp > XB_SPIN_CAP) { atomicAdd(&bar[XB_TMO], 1u); break; } }
  }
  nloc = mine > 0u ? mine : 1u; nx = cnt > 0u ? cnt : 1u;
}
DI void xcd_barrier(const XcdBarrier& b) {
  asm volatile("s_waitcnt vmcnt(0)" ::: "memory");
  __syncthreads();
  if (__builtin_amdgcn_workitem_id_x() == 0) {
    unsigned* bar = b.bar;
    __builtin_amdgcn_s_waitcnt(0);
    unsigned nloc = b.st[0], nx = b.st[1];
    if (nloc == 0u) { xcd_barrier_complete(bar, b.x, nloc, nx); b.st[0] = nloc; b.st[1] = nx; }
    const unsigned old = xb_add(&bar[XB_XSUB(b.x)], 1u);
    const unsigned gen = old / nloc;
    if (old + 1u == (gen + 1u) * nloc) {
      __builtin_amdgcn_fence(__ATOMIC_RELEASE, "agent");
      asm volatile("s_waitcnt vmcnt(0)" ::: "memory");
      const unsigned og = xb_add(&bar[XB_TOP], 1u);
      const unsigned tg = og / nx;
      if (og + 1u == (tg + 1u) * nx) xb_add(&bar[XB_TOPGEN], 1u);
      else XB_SPIN(xb_ld(&bar[XB_TOPGEN]) == tg, bar);
      __builtin_amdgcn_fence(__ATOMIC_ACQUIRE, "agent");
      xb_add(&bar[XB_XGEN(b.x)], 1u);
      asm volatile("s_waitcnt vmcnt(0)" ::: "memory");
    } else {
      XB_SPIN(xb_ld(&bar[XB_XGEN(b.x)]) == gen, bar);
      __builtin_amdgcn_fence(__ATOMIC_ACQUIRE, "agent");
      asm volatile("s_waitcnt vmcnt(0)" ::: "memory");
    }
  }
  __syncthreads();
}

template <int NT>
DI void gemm_main_np(f32x16 (&acc)[2][NT], const u16* __restrict__ A, int lda, int amode, const u16* __restrict__ Bt,
                  int ldb, int K, char* smem) {
  constexpr int LS = 72;
  constexpr int TILE = (128 + 64 * NT) * LS;
  u16* S = (u16*)smem;
  const int tid = tidx(), lane = tid & 63, w = tid >> 6, wm = w >> 1, wn = w & 1;
  const int l31 = lane & 31, hh = lane >> 5;
  const int lr = tid >> 3, lk = (tid & 7) * 8;
  u32x4 ra[4], rb[2 * NT];
#define GEMM_LOADG(kk) { const int ka_ = amode ? (((kk) >> 6) * 96) : (kk); \
    _Pragma("unroll") for (int i = 0; i < 4; ++i) ra[i] = *(const u32x4*)(A + (size_t)(lr + 32 * i) * lda + ka_ + lk); \
    _Pragma("unroll") for (int i = 0; i < 2 * NT; ++i) rb[i] = *(const u32x4*)(Bt + (size_t)(lr + 32 * i) * ldb + (kk) + lk); }
#define GEMM_STORES(buf) { u16* As_ = S + (buf) * TILE; u16* Bs_ = As_ + 128 * LS; \
    _Pragma("unroll") for (int i = 0; i < 4; ++i) *(u32x4*)(As_ + (lr + 32 * i) * LS + lk) = ra[i]; \
    _Pragma("unroll") for (int i = 0; i < 2 * NT; ++i) *(u32x4*)(Bs_ + (lr + 32 * i) * LS + lk) = rb[i]; }
  GEMM_LOADG(0)
  __syncthreads();
  GEMM_STORES(0)
  if (K > 64) GEMM_LOADG(64)
  __syncthreads();
  for (int k0 = 0; k0 < K; k0 += 64) {
    const int cur = (k0 >> 6) & 1;
    if (k0 + 64 < K) {
      GEMM_STORES(cur ^ 1)
      if (k0 + 128 < K) GEMM_LOADG(k0 + 128)
    }
    const u16* As = S + cur * TILE;
    const u16* Bs = As + 128 * LS;
#pragma unroll
    for (int s = 0; s < 4; ++s) {
      bf16x8 a[2], b[NT];
#pragma unroll
      for (int i = 0; i < 2; ++i) a[i] = *(const bf16x8*)(As + (wm * 64 + i * 32 + l31) * LS + s * 16 + hh * 8);
#pragma unroll
      for (int j = 0; j < NT; ++j) b[j] = *(const bf16x8*)(Bs + (wn * 32 * NT + j * 32 + l31) * LS + s * 16 + hh * 8);
#pragma unroll
      for (int i = 0; i < 2; ++i)
#pragma unroll
        for (int j = 0; j < NT; ++j) acc[i][j] = MFMA32(a[i], b[j], acc[i][j]);
    }
    __syncthreads();
  }
#undef GEMM_LOADG
#undef GEMM_STORES
}


#define SCHED_FENCE() asm volatile("" ::: "memory")
template <int NT>
DI void gemm_main(f32x16 (&acc)[2][NT], const u16* __restrict__ A, int lda, int amode, const u16* __restrict__ Bt,
                  int ldb, int K, char* smem) {
  constexpr int LS = 72;
  constexpr int TILE = (128 + 64 * NT) * LS;
  constexpr int NB2 = 2 * NT;
  u16* S = (u16*)smem;
  const int tid = tidx(), lane = tid & 63, w = tid >> 6, wm = w >> 1, wn = w & 1;
  const int l31 = lane & 31, hh = lane >> 5;
  const int lr = tid >> 3, lk = (tid & 7) * 8;
  u32x4 ra0[4], rb0[NB2], ra1[4], rb1[NB2];
#define G_LOAD(RA, RB, kk) { const int ka_ = amode ? (((kk) >> 6) * 96) : (kk); \
    _Pragma("unroll") for (int i = 0; i < 4; ++i) RA[i] = *(const u32x4*)(A + (size_t)(lr + 32 * i) * lda + ka_ + lk); \
    _Pragma("unroll") for (int i = 0; i < NB2; ++i) RB[i] = *(const u32x4*)(Bt + (size_t)(lr + 32 * i) * ldb + (kk) + lk); }
#define G_STORE_A(RA, buf, i) *(u32x4*)(S + (buf) * TILE + (lr + 32 * (i)) * LS + lk) = RA[i];
#define G_STORE_B(RB, buf, i) *(u32x4*)(S + (buf) * TILE + 128 * LS + (lr + 32 * (i)) * LS + lk) = RB[i];
#define G_STEP(RA, RB, cur, s, do_st) { \
    if (do_st) { G_STORE_A(RA, (cur) ^ 1, s) \
      _Pragma("unroll") for (int i = 0; i < NB2 / 4; ++i) G_STORE_B(RB, (cur) ^ 1, (s) * (NB2 / 4) + i) \
      if (NB2 < 4 && ((s) & 1) == 0) G_STORE_B(RB, (cur) ^ 1, (s) >> 1) } \
    SCHED_FENCE(); \
    const u16* As_ = S + (cur) * TILE; const u16* Bs_ = As_ + 128 * LS; \
    bf16x8 a_[2], b_[NT]; \
    _Pragma("unroll") for (int i = 0; i < 2; ++i) a_[i] = *(const bf16x8*)(As_ + (wm * 64 + i * 32 + l31) * LS + (s) * 16 + hh * 8); \
    _Pragma("unroll") for (int j = 0; j < NT; ++j) b_[j] = *(const bf16x8*)(Bs_ + (wn * 32 * NT + j * 32 + l31) * LS + (s) * 16 + hh * 8); \
    _Pragma("unroll") for (int i = 0; i < 2; ++i) _Pragma("unroll") for (int j = 0; j < NT; ++j) acc[i][j] = MFMA32(a_[i], b_[j], acc[i][j]); \
    SCHED_FENCE(); }
  const int nk = K >> 6;
  G_LOAD(ra0, rb0, 0)
  __syncthreads();
#pragma unroll
  for (int i = 0; i < 4; ++i) G_STORE_A(ra0, 0, i)
#pragma unroll
  for (int i = 0; i < NB2; ++i) G_STORE_B(rb0, 0, i)
  G_LOAD(ra0, rb0, 64)
  __syncthreads();
  for (int kt = 0; kt < nk; kt += 2) {
    const bool more2 = kt + 2 < nk;
    if (more2) G_LOAD(ra1, rb1, (kt + 2) * 64)
    G_STEP(ra0, rb0, 0, 0, true) G_STEP(ra0, rb0, 0, 1, true) G_STEP(ra0, rb0, 0, 2, true) G_STEP(ra0, rb0, 0, 3, true)
    __syncthreads();
    if (kt + 3 < nk) G_LOAD(ra0, rb0, (kt + 3) * 64)
    G_STEP(ra1, rb1, 1, 0, more2) G_STEP(ra1, rb1, 1, 1, more2) G_STEP(ra1, rb1, 1, 2, more2) G_STEP(ra1, rb1, 1, 3, more2)
    __syncthreads();
  }
#undef G_LOAD
#undef G_STORE_A
#undef G_STORE_B
#undef G_STEP
}

DI void gemm_wide(f32x16 (&acc)[2][4], const u16* __restrict__ A, int lda, const u16* __restrict__ Bt, int ldb, int K,
                  char* smem) {
  constexpr int LS = 72;
  u16* As = (u16*)smem;
  u16* Bs = As + 128 * LS;
  const int tid = tidx(), lane = tid & 63, w = tid >> 6, wm = w >> 1, wn = w & 1;
  const int l31 = lane & 31, hh = lane >> 5;
  const int lr = tid >> 3, lk = (tid & 7) * 8;
  u32x4 ra[4], rb[8];
#pragma unroll
  for (int i = 0; i < 4; ++i) ra[i] = *(const u32x4*)(A + (size_t)(lr + 32 * i) * lda + lk);
#pragma unroll
  for (int i = 0; i < 8; ++i) rb[i] = *(const u32x4*)(Bt + (size_t)(lr + 32 * i) * ldb + lk);
  for (int k0 = 0; k0 < K; k0 += 64) {
    __syncthreads();
#pragma unroll
    for (int i = 0; i < 4; ++i) *(u32x4*)(As + (lr + 32 * i) * LS + lk) = ra[i];
#pragma unroll
    for (int i = 0; i < 8; ++i) *(u32x4*)(Bs + (lr + 32 * i) * LS + lk) = rb[i];
    __syncthreads();
    if (k0 + 64 < K) {
      const int k1 = k0 + 64 + lk;
#pragma unroll
      for (int i = 0; i < 4; ++i) ra[i] = *(const u32x4*)(A + (size_t)(lr + 32 * i) * lda + k1);
#pragma unroll
      for (int i = 0; i < 8; ++i) rb[i] = *(const u32x4*)(Bt + (size_t)(lr + 32 * i) * ldb + k1);
    }
#pragma unroll
    for (int s = 0; s < 4; ++s) {
      bf16x8 a[2], b[4];
#pragma unroll
      for (int i = 0; i < 2; ++i) a[i] = *(const bf16x8*)(As + (wm * 64 + i * 32 + l31) * LS + s * 16 + hh * 8);
#pragma unroll
      for (int j = 0; j < 4; ++j) b[j] = *(const bf16x8*)(Bs + (wn * 128 + j * 32 + l31) * LS + s * 16 + hh * 8);
#pragma unroll
      for (int i = 0; i < 2; ++i)
#pragma unroll
        for (int j = 0; j < 4; ++j) acc[i][j] = MFMA32(a[i], b[j], acc[i][j]);
    }
  }
  __syncthreads();
}

DI void tile_map(int u, int MT, int NT, int& mt, int& nt, int PW = 8) {
  const int xcd = u & 7;
  int j = u >> 3;
  const int ML = MT >> 3;
  const int P = (NT + PW - 1) / PW, wlo = NT / P, rem = NT - wlo * P;
  int nstart = 0, width = wlo;
#pragma unroll 1
  for (int pn = 0; pn < P; ++pn) {
    width = wlo + (pn < rem ? 1 : 0);
    const int cnt = ML * width;
    if (j < cnt) break;
    j -= cnt; nstart += width;
  }
  const int mi = j / width;
  mt = mi * 8 + xcd;
  nt = nstart + (j - mi * width);
}

DI void p0_mods(KP p, int u, char* smem) {
  const int l = u / 192, n0 = (u % 192) * 32;
  float* ss = (float*)smem;
  float* red = ss + 5 * 1024;
  const int tid = tidx();
  __syncthreads();
  for (int i = tid; i < 5 * 1024; i += 256) {
    int ci = i >> 10, k = i & 1023;
    float v = (ci < 4) ? p->c[ci * 1024 + k] : p->c_ctx[k];
    ss[i] = v / (1.f + __expf(-v));
  }
  __syncthreads();
  const int kg = tid >> 5, cc = tid & 31;
  float a0 = 0, a1 = 0, a2 = 0, a3 = 0, a4 = 0;
  const float* wp = p->ada_w + (size_t)l * 1024 * 6144 + n0 + cc;
#pragma unroll 16
  for (int k = kg; k < 1024; k += 8) {
    float wv = wp[(size_t)k * 6144];
    a0 += ss[k] * wv; a1 += ss[1024 + k] * wv; a2 += ss[2048 + k] * wv; a3 += ss[3072 + k] * wv; a4 += ss[4096 + k] * wv;
  }
  red[(kg * 5 + 0) * 32 + cc] = a0; red[(kg * 5 + 1) * 32 + cc] = a1; red[(kg * 5 + 2) * 32 + cc] = a2;
  red[(kg * 5 + 3) * 32 + cc] = a3; red[(kg * 5 + 4) * 32 + cc] = a4;
  __syncthreads();
  if (tid < 160) {
    int ci = tid >> 5, c2 = tid & 31;
    float s = 0;
#pragma unroll
    for (int g = 0; g < 8; ++g) s += red[(g * 5 + ci) * 32 + c2];
    float* mods = (float*)(p->ws + OFF_MODS);
    mods[(l * 5 + ci) * 6144 + n0 + c2] = s + p->ada_b[l * 6144 + n0 + c2];
  }
}

DI void p0_tw(KP p, int u) {
  int k = u * 256 + tidx();
  float s, c;
  sincospif((float)k * (1.f / 4096.f), &s, &c);
  f32x2* tw = (f32x2*)(p->ws + OFF_TW);
  tw[k] = mkf2(c, -s);
}

DI void p0_hid(KP p, int u, char* smem) {
  const int tid = tidx(), lane = tid & 63, w = tid >> 6;
  const int gr = u * 4 + w;
  int l, n, t;
  float* dst;
  if (gr < 4096) { l = 0; n = 4096; t = gr; dst = (float*)(p->ws + OFF_HID) + (size_t)t * 64; }
  else if (gr < 8192) { l = 1; n = 4096; t = gr - 4096; dst = (float*)(p->ws + OFF_HID) + (size_t)(4096 + t) * 64; }
  else { l = 0; n = 256; t = gr - 8192; dst = (float*)(p->ws + OFF_HID256) + (size_t)t * 64; }
  float* zb = (float*)smem + w * 128;
  __syncthreads();
  if (lane < 33) {
    float v;
    if (lane == 0) v = (float)t / (float)(n - 1);
    else {
      int k = (lane - 1) & 15;
      float wt = (6.283185307179586f * (float)t) / (float)n;
      float f = 1e-4f + (float)k * ((15.f - 1e-4f) / 15.f);
      float ang = wt * f;
      v = (lane <= 16) ? cosf(ang) : -sinf(ang);
    }
    zb[lane] = v;
  }
  __syncthreads();
  const float fr = p->hy_freq[l * 64 + lane];
  float acc = p->hy_b1[l * 64 + lane];
#pragma unroll
  for (int i = 0; i < 33; ++i) acc += zb[i] * p->hy_w1[(l * 33 + i) * 64 + lane];
  float h = sinf(fr * acc);
  __syncthreads();
  zb[lane] = h;
  __syncthreads();
  for (int j2 = 0; j2 < 2; ++j2) {
    float a2 = p->hy_b2[(l * 2 + j2) * 64 + lane];
#pragma unroll
    for (int i = 0; i < 64; ++i) a2 += zb[i] * p->hy_w2[((l * 2 + j2) * 64 + i) * 64 + lane];
    h = sinf(fr * a2);
    __syncthreads();
    zb[lane] = h;
    __syncthreads();
  }
  dst[lane] = h;
}

enum { J_WINS = 0, J_WING, J_WUQ, J_WUKV, J_WBRA, J_WBRB, J_WBRC, J_WOUT, J_WGU, J_WDN };
DI float wsrc(KP p, int job, int l, int k, int n) {
  switch (job) {
    case J_WINS: {
      int c;
      if (n < 672) c = n; else if (n < 768) return 0.f; else c = n - 96;
      return p->w_in[((size_t)l * 1024 + k) * INW + c];
    }
    case J_WING: return p->w_in[((size_t)l * 1024 + k) * INW + 3232 + n];
    case J_WUQ: return p->w_uq[((size_t)l * 384 + k) * 768 + n] * p->q_norm_g[l * 384 + k];
    case J_WUKV: return p->w_ukv[((size_t)l * 256 + k) * 1024 + n] * p->kv_norm_g[l * 256 + k];
    case J_WBRA: return p->w_br_a[((size_t)l * 512 + k) * 1024 + n];
    case J_WBRB: return p->w_br_b[((size_t)l * 512 + k) * 1024 + n];
    case J_WBRC: return p->w_br_c[((size_t)l * 512 + k) * 1024 + n];
    case J_WOUT: return p->w_out[((size_t)l * 1024 + k) * 1024 + n];
    case J_WGU: {
      int T = n >> 7, wn = (n >> 6) & 1, j = (n >> 5) & 1, e = n & 31;
      int uu = T * 64 + wn * 32 + e;
      const float* s = j ? p->ffn_w_up : p->ffn_w_gate;
      return s[((size_t)l * 1024 + k) * FFN + uu];
    }
    default: return p->ffn_w_down[((size_t)l * FFN + k) * 1024 + n];
  }
}
DI void conv_tile(KP p, u16* dst, int K, int job, int l, int nt, int kt, char* smem) {
  float* tile = (float*)smem;
  const int tid = tidx();
  __syncthreads();
  {
    const int n = nt * 64 + (tid & 63), kb = kt * 64 + (tid >> 6) * 16;
#pragma unroll
    for (int i = 0; i < 16; ++i) tile[((tid >> 6) * 16 + i) * 65 + (tid & 63)] = wsrc(p, job, l, kb + i, n);
  }
  __syncthreads();
  {
    const int nl = tid >> 2, kq = (tid & 3) * 16;
    unsigned v[8];
#pragma unroll
    for (int j = 0; j < 8; ++j) v[j] = pack2(tile[(kq + 2 * j) * 65 + nl], tile[(kq + 2 * j + 1) * 65 + nl]);
    u16* d = dst + (size_t)(nt * 64 + nl) * K + kt * 64 + kq;
    *(u32x4*)d = u32x4{v[0], v[1], v[2], v[3]};
    *(u32x4*)(d + 8) = u32x4{v[4], v[5], v[6], v[7]};
  }
}
constexpr int CV1_TILES = 832 + 768 + 72 + 64 + 384 + 256;
constexpr int CV1_UNITS = CV1_TILES + 64;
DI void conv_stage1(KP p, int l, int u, char* smem) {
  u16* W = (u16*)(p->ws + OFF_W);
  if (u < 832) { conv_tile(p, W + W_INS, 1024, J_WINS, l, u >> 4, u & 15, smem); return; }
  u -= 832;
  if (u < 768) { conv_tile(p, W + W_ING, 1024, J_WING, l, u >> 4, u & 15, smem); return; }
  u -= 768;
  if (u < 72) { conv_tile(p, W + W_UQ, 384, J_WUQ, l, u / 6, u % 6, smem); return; }
  u -= 72;
  if (u < 64) { conv_tile(p, W + W_UKV, 256, J_WUKV, l, u >> 2, u & 3, smem); return; }
  u -= 64;
  if (u < 384) {
    int br = u >> 7, r = u & 127;
    conv_tile(p, W + W_BRA + (size_t)br * 1024 * 512, 512, J_WBRA + br, l, r >> 3, r & 7, smem);
    return;
  }
  u -= 384;
  if (u < 256) { conv_tile(p, W + W_OUT, 1024, J_WOUT, l, u >> 4, u & 15, smem); return; }
  u -= 256;
  for (int e = 0; e < 8; ++e) {
    int idx = (u * 8 + e) * 256 + tidx();
    int g = idx >> 14, n = (idx >> 6) & 255, i = idx & 63;
    int mat = n >> 6, j = n & 63, dir = mat >> 1;
    const float* src = (mat & 1) ? p->lru_wx : p->lru_wa;
    W[W_LRU + idx] = f2bf(src[((((size_t)l * 2 + dir) * 8 + g) * 64 + i) * 64 + j]);
  }
}
constexpr int CV2_UNITS = 1408 + 704;
DI void conv_stage2(KP p, int l, int u, char* smem) {
  u16* W = (u16*)(p->ws + OFF_W);
  if (u < 1408) { conv_tile(p, W + W_GU, 1024, J_WGU, l, u >> 4, u & 15, smem); return; }
  u -= 1408;
  conv_tile(p, W + W_DN, FFN, J_WDN, l, u / 44, u % 44, smem);
}


DI void filt_unit(KP p, int l, int u) {
  const int tb = u >> 6, cb = u & 63;
  const int t = tb * 256 + tidx();
  const float* hr = (const float*)(p->ws + OFF_HID) + ((size_t)l * 4096 + t) * 64;
  const float* wout = p->hy_w_out + (size_t)l * 64 * 2048 + cb * 32;
  float acc[32];
#pragma unroll
  for (int cc = 0; cc < 32; ++cc) acc[cc] = 0.f;
#pragma unroll 4
  for (int j4 = 0; j4 < 16; ++j4) {
    const f32x4 hv = *(const f32x4*)(hr + 4 * j4);
    const float* w0 = wout + (size_t)(4 * j4) * 2048;
#pragma unroll
    for (int cc = 0; cc < 32; ++cc)
      acc[cc] += hv.x * w0[cc] + hv.y * w0[2048 + cc] + hv.z * w0[4096 + cc] + hv.w * w0[6144 + cc];
  }
  const float mind = -4.605170185988091f / 1.5f, maxd = -4.605170185988091f / 0.3f;
  const float tl = (float)t / 4095.f;
  u16* F = (u16*)(p->ws + OFF_FILT);
#pragma unroll
  for (int cc = 0; cc < 32; ++cc) {
    const int col = cb * 32 + cc, c = col & 511;
    const float delta = fabsf(mind + (float)c * ((maxd - mind) / 511.f));
    F[(size_t)col * 4096 + t] = f2bf(acc[cc] * expf(-tl * delta));
  }
}

DI void norm_rows(KP p, int l, int which, int u, const float* xlat, const float* xctx) {
  const int lane = tidx() & 63, w = tidx() >> 6;
  const int row = u * 4 + w;
  int b, t, isctx;
  rowinfo(row, b, t, isctx);
  const float* xr = isctx ? (xctx + (size_t)(row - MLAT) * 1024) : (xlat + (size_t)row * 1024);
  const int ci = isctx ? 4 : b;
  const float* mods = (const float*)(p->ws + OFF_MODS) + (size_t)(l * 5 + ci) * 6144 + which * 3072;
  const float* g = (which ? p->norm2_g : p->norm1_g) + l * 1024;
  f32x4 v[4];
  float ss = 0;
#pragma unroll
  for (int j = 0; j < 4; ++j) {
    v[j] = *(const f32x4*)(xr + 4 * (lane + 64 * j));
    ss += v[j].x * v[j].x + v[j].y * v[j].y + v[j].z * v[j].z + v[j].w * v[j].w;
  }
  ss = wave_sum(ss);
  const float rstd = rsqrtf(ss * (1.f / 1024.f) + EPS);
  u16* H = (u16*)(p->ws + OFF_H) + (size_t)row * 1024;
#pragma unroll
  for (int j = 0; j < 4; ++j) {
    const int c0 = 4 * (lane + 64 * j);
    f32x4 gg = *(const f32x4*)(g + c0), sh = *(const f32x4*)(mods + c0), sc = *(const f32x4*)(mods + 1024 + c0);
    float o0 = v[j].x * rstd * gg.x * (1.f + sc.x) + sh.x;
    float o1 = v[j].y * rstd * gg.y * (1.f + sc.y) + sh.y;
    float o2 = v[j].z * rstd * gg.z * (1.f + sc.z) + sh.z;
    float o3 = v[j].w * rstd * gg.w * (1.f + sc.w) + sh.w;
    *(u32x2*)(H + c0) = mk2(pack2(o0, o1), pack2(o2, o3));
  }
}

DI void p2_inproj(KP p, int u, char* smem) {
  int mt, nt; tile_map(u, 136, 13, mt, nt, PANEL_W);
  const int lane = tidx() & 63, w = tidx() >> 6, wm = w >> 1, wn = w & 1, l31 = lane & 31, hh = lane >> 5;
  f32x16 acc[2][4];
#pragma unroll
  for (int i = 0; i < 2; ++i)
#pragma unroll
    for (int j = 0; j < 4; ++j) zero_acc(acc[i][j]);
  const u16* H = (const u16*)(p->ws + OFF_H);
  const u16* W = (const u16*)(p->ws + OFF_W) + W_INS;
  gemm_wide(acc, H + (size_t)mt * 128 * 1024, 1024, W + (size_t)nt * 256 * 1024, 1024, 1024, smem);
#pragma unroll
  for (int i = 0; i < 2; ++i)
#pragma unroll
    for (int j = 0; j < 4; ++j) {
      const int mrow0 = mt * 128 + wm * 64 + i * 32;
      const int n = nt * 256 + wn * 128 + j * 32 + l31;
      if (nt < 3) {
        if (n < 672) {
          store_tile_bf16((u16*)(p->ws + OFF_ZMLA) + (size_t)mrow0 * 672 + (n - l31), 672, acc[i][j], l31, hh);
        }
      } else if (nt < 7) {
        u16* Z = (u16*)(p->ws + (nt < 5 ? OFF_ZLX : OFF_ZLG));
        const int cc = n - (nt < 5 ? 768 : 1280);
        store_tile_bf16(Z + (size_t)mrow0 * 512 + (cc - l31), 512, acc[i][j], l31, hh);
      } else {
        const int ch = n - 1792;
        u16* dst;
        if (mrow0 < MLAT) dst = (u16*)(p->ws + OFF_ZHY) + ((size_t)((mrow0 >> 12) * 1536 + ch)) * 4096 + (mrow0 & 4095);
        else { int rr = mrow0 - MLAT; dst = (u16*)(p->ws + OFF_ZHC) + ((size_t)((rr >> 8) * 1536 + ch)) * 256 + (rr & 255); }
#pragma unroll
        for (int q = 0; q < 4; ++q)
          *(u32x2*)(dst + 8 * q + 4 * hh) = mk2(pack2(acc[i][j][4 * q], acc[i][j][4 * q + 1]), pack2(acc[i][j][4 * q + 2], acc[i][j][4 * q + 3]));
      }
    }
}


DI void p2_inproj_half(KP p, int hu, char* smem) {
  int mt, ntw; tile_map(1536 + (hu >> 1), 136, 13, mt, ntw, PANEL_W);
  const int nt = ntw * 2 + (hu & 1);
  const int lane = tidx() & 63, w = tidx() >> 6, wm = w >> 1, wn = w & 1, l31 = lane & 31, hh = lane >> 5;
  f32x16 acc[2][2];
#pragma unroll
  for (int i = 0; i < 2; ++i)
#pragma unroll
    for (int j = 0; j < 2; ++j) zero_acc(acc[i][j]);
  const u16* H = (const u16*)(p->ws + OFF_H);
  const u16* W = (const u16*)(p->ws + OFF_W) + W_INS;
  gemm_main_np<2>(acc, H + (size_t)mt * 128 * 1024, 1024, 0, W + (size_t)nt * 128 * 1024, 1024, 1024, smem);
#pragma unroll
  for (int i = 0; i < 2; ++i)
#pragma unroll
    for (int j = 0; j < 2; ++j) {
      const int mrow0 = mt * 128 + wm * 64 + i * 32;
      const int n = nt * 128 + wn * 64 + j * 32 + l31;
      if (nt < 6) {
        if (n < 672) {
          store_tile_bf16((u16*)(p->ws + OFF_ZMLA) + (size_t)mrow0 * 672 + (n - l31), 672, acc[i][j], l31, hh);
        }
      } else if (nt < 14) {
        u16* Z = (u16*)(p->ws + (nt < 10 ? OFF_ZLX : OFF_ZLG));
        const int cc = n - (nt < 10 ? 768 : 1280);
        store_tile_bf16(Z + (size_t)mrow0 * 512 + (cc - l31), 512, acc[i][j], l31, hh);
      } else {
        const int ch = n - 1792;
        u16* dst;
        if (mrow0 < MLAT) dst = (u16*)(p->ws + OFF_ZHY) + ((size_t)((mrow0 >> 12) * 1536 + ch)) * 4096 + (mrow0 & 4095);
        else { int rr = mrow0 - MLAT; dst = (u16*)(p->ws + OFF_ZHC) + ((size_t)((rr >> 8) * 1536 + ch)) * 256 + (rr & 255); }
#pragma unroll
        for (int q = 0; q < 4; ++q)
          *(u32x2*)(dst + 8 * q + 4 * hh) = mk2(pack2(acc[i][j][4 * q], acc[i][j][4 * q + 1]), pack2(acc[i][j][4 * q + 2], acc[i][j][4 * q + 3]));
      }
    }
}

DI void rope_consts(int e, int t, float& sn, float& cs) {
  const int i8 = e & 7;
  const float inv = __builtin_amdgcn_exp2f(-(float)i8 * 1.6609640474436813f);
  const float pos = (e < 16) ? (float)(t >> 6) : (float)(t & 63);
  const float rev = pos * inv * 0.15915494309189535f;
  sn = __builtin_amdgcn_sinf(rev);
  cs = __builtin_amdgcn_cosf(rev);
}
DI void row_rstd(const u16* Z, int row0, int col0, int ncol, float* rs) {
  const int tid = tidx(), rl = tid >> 1, half = tid & 1, per = ncol >> 1;
  const u16* src = Z + (size_t)(row0 + rl) * 672 + col0 + half * per;
  float s = 0;
  for (int i = 0; i < per; i += 8) {
    u32x4 v = *(const u32x4*)(src + i);
    unsigned vv[4] = {v.x, v.y, v.z, v.w};
#pragma unroll
    for (int q = 0; q < 4; ++q) {
      float a = __uint_as_float(vv[q] << 16), b = __uint_as_float(vv[q] & 0xffff0000u);
      s += a * a + b * b;
    }
  }
  s += __shfl_xor(s, 1);
  if (half == 0) rs[rl] = rsqrtf(s / (float)ncol + EPS);
}
DI void p3_qproj(KP p, int u, char* smem) {
  int mt, nt; tile_map(u, 136, 6, mt, nt);
  const int lane = tidx() & 63, w = tidx() >> 6, wm = w >> 1, wn = w & 1, l31 = lane & 31, hh = lane >> 5;
  float* rs = (float*)(smem + 73728);
  const u16* Z = (const u16*)(p->ws + OFF_ZMLA);
  __syncthreads();
  row_rstd(Z, mt * 128, 0, 384, rs);
  f32x16 acc[2][2];
#pragma unroll
  for (int i = 0; i < 2; ++i)
#pragma unroll
    for (int j = 0; j < 2; ++j) zero_acc(acc[i][j]);
  const u16* W = (const u16*)(p->ws + OFF_W) + W_UQ;
  gemm_main<2>(acc, Z + (size_t)mt * 128 * 672, 672, 0, W + (size_t)nt * 128 * 384, 384, 384, smem);
  u16* Q = (u16*)(p->ws + OFF_Q);
  const bool lat = (mt * 128) < MLAT;
#pragma unroll
  for (int i = 0; i < 2; ++i)
#pragma unroll
    for (int j = 0; j < 2; ++j) {
      const int ml0 = wm * 64 + i * 32;
      const int n0 = nt * 128 + wn * 64 + j * 32;
      const int e0 = n0 % 96;
      const bool rope = lat && (e0 == 64);
#pragma unroll
      for (int r = 0; r < 16; ++r) {
        const int ml = ml0 + crow(r, hh);
        const int row = mt * 128 + ml;
        float v = acc[i][j][r] * rs[ml];
        if (rope) {
          float sn, cs;
          rope_consts(l31, row & 4095, sn, cs);
          float pr = __shfl_xor(v, 8);
          v = (l31 & 8) ? (v * cs + pr * sn) : (v * cs - pr * sn);
        }
        Q[(size_t)row * 768 + n0 + l31] = f2bf(v);
      }
    }
}
DI void p3_kvproj(KP p, int u, char* smem) {
  int mt, nt; tile_map(u, 136, 8, mt, nt);
  const int lane = tidx() & 63, w = tidx() >> 6, wm = w >> 1, wn = w & 1, l31 = lane & 31, hh = lane >> 5;
  float* rs = (float*)(smem + 73728);
  const u16* Z = (const u16*)(p->ws + OFF_ZMLA);
  __syncthreads();
  row_rstd(Z, mt * 128, 384, 256, rs);
  f32x16 acc[2][2];
#pragma unroll
  for (int i = 0; i < 2; ++i)
#pragma unroll
    for (int j = 0; j < 2; ++j) zero_acc(acc[i][j]);
  const u16* W = (const u16*)(p->ws + OFF_W) + W_UKV;
  gemm_main<2>(acc, Z + (size_t)mt * 128 * 672 + 384, 672, 0, W + (size_t)nt * 128 * 256, 256, 256, smem);
  u16* Kb = (u16*)(p->ws + OFF_K);
  u16* Vt = (u16*)(p->ws + OFF_VT);
  int b, t0, isctx;
  rowinfo(mt * 128, b, t0, isctx);
  const int key_base = isctx ? t0 : (256 + t0);
#pragma unroll
  for (int i = 0; i < 2; ++i)
#pragma unroll
    for (int j = 0; j < 2; ++j) {
      const int ml0 = wm * 64 + i * 32;
      if (wn == 0) {
        const int e = j * 32 + l31;
#pragma unroll
        for (int r = 0; r < 16; ++r) {
          const int ml = ml0 + crow(r, hh);
          Kb[((size_t)(b * 8 + nt) * NKEY + key_base + ml) * 96 + e] = f2bf(acc[i][j][r] * rs[ml]);
        }
      } else {
        const int dv = j * 32 + l31;
        u16* dst = Vt + ((size_t)(b * 8 + nt) * 64 + dv) * NKEY + key_base + ml0;
#pragma unroll
        for (int q = 0; q < 4; ++q) {
          const int mlq = ml0 + 8 * q + 4 * hh;
          *(u32x2*)(dst + 8 * q + 4 * hh) =
              mk2(pack2(acc[i][j][4 * q] * rs[mlq], acc[i][j][4 * q + 1] * rs[mlq + 1]),
                         pack2(acc[i][j][4 * q + 2] * rs[mlq + 2], acc[i][j][4 * q + 3] * rs[mlq + 3]));
        }
      }
    }
}
DI void p3_kpe(KP p, int u) {
  const int row = u * 8 + (tidx() >> 5), e = tidx() & 31;
  const u16* Z = (const u16*)(p->ws + OFF_ZMLA) + (size_t)row * 672 + 640;
  float v = bf2f(Z[e]), pr = bf2f(Z[e ^ 8]);
  int b, t, isctx;
  rowinfo(row, b, t, isctx);
  if (!isctx) {
    float sn, cs;
    rope_consts(e, t, sn, cs);
    v = (e & 8) ? (v * cs + pr * sn) : (v * cs - pr * sn);
  }
  const int key = isctx ? t : 256 + t;
  u16* Kb = (u16*)(p->ws + OFF_K);
  const u16 o = f2bf(v);
#pragma unroll
  for (int hd = 0; hd < 8; ++hd) Kb[((size_t)(b * 8 + hd) * NKEY + key) * 96 + 64 + e] = o;
}

DI void lru_unit(KP p, int l, int u, int pass, char* smem, int dummy = 0) {
  const int b = u / 544, rem = u % 544, j = rem >> 3, g = rem & 7;
  const int tid = tidx(), lane = tid & 63, w = tid >> 6, l31 = lane & 31, hh = lane >> 5;
  u16* Au = (u16*)smem;
  float* uf = (float*)(smem + 9216);
  float* sa = (float*)(smem + 25856);
  float* sb = (float*)(smem + 42496);
  float* carry = (float*)(smem + 59136);
  int base, seglen, tpos0;
  if (j < 4) { base = MLAT + b * 256 + j * 64; seglen = 256; tpos0 = j * 64; }
  else { base = b * 4096 + (j - 4) * 64; seglen = 4096; tpos0 = (j - 4) * 64; }
  const u16* Zlx = (const u16*)(p->ws + OFF_ZLX);
  f32x2* agg = (f32x2*)(p->ws + OFF_AGG);
  __syncthreads();
  {
    const int c = tid & 63, tq = tid >> 6, cg = g * 64 + c;
    const float w0 = p->lru_conv_w[(l * 4 + 0) * 512 + cg], w1 = p->lru_conv_w[(l * 4 + 1) * 512 + cg];
    const float w2 = p->lru_conv_w[(l * 4 + 2) * 512 + cg], w3 = p->lru_conv_w[(l * 4 + 3) * 512 + cg];
    const float bias = p->lru_conv_b[l * 512 + cg];
    auto ld = [&](int tt) -> float {
      int tp = tpos0 + tt;
      return (tp >= 0 && tp < seglen) ? bf2f(Zlx[(size_t)(base + tt) * 512 + cg]) : 0.f;
    };
    const int t0 = tq * 16;
    float xv[19];
#pragma unroll
    for (int e = 0; e < 19; ++e) xv[e] = ld(t0 - 2 + e);
#pragma unroll
    for (int tt = 0; tt < 16; ++tt) {
      const float y = w0 * xv[tt] + w1 * xv[tt + 1] + w2 * xv[tt + 2] + w3 * xv[tt + 3] + bias;
      uf[(t0 + tt) * 65 + c] = y;
      Au[(t0 + tt) * 72 + c] = f2bf(y);
    }
  }
  if (pass == 3) {
    const int part = tid >> 7, dir = (tid >> 6) & 1, c = tid & 63, cg = g * 64 + c;
    const f32x2* ag = agg + ((size_t)(b * 68) * 2 + dir) * 512 + cg;
    f32x2 ab[34];
#pragma unroll
    for (int e = 0; e < 34; ++e) {
      const int sl = part * 34 + e;
      int ch; bool valid;
      if (dir == 0) { ch = sl; valid = sl < j; }
      else { ch = (sl < 4) ? (3 - sl) : (71 - sl); valid = (j < 4) ? (sl < 4 && ch > j) : (sl < 4 || ch > j); }
      ab[e] = valid ? ag[(size_t)ch * 1024] : mkf2(1.f, 0.f);
    }
    float A = 1.f, Bv = 0.f;
#pragma unroll
    for (int e = 0; e < 34; ++e) { A *= ab[e].x; Bv = ab[e].x * Bv + ab[e].y; }
    ((f32x2*)carry)[(part * 2 + dir) * 64 + c] = mkf2(A, Bv);
  }
  __syncthreads();
  const int th = w >> 1, chh = w & 1;
  f32x16 acc[4];
#pragma unroll
  for (int m = 0; m < 4; ++m) zero_acc(acc[m]);
  const u16* Wl = (const u16*)(p->ws + OFF_W) + W_LRU + (size_t)g * 256 * 64;
#pragma unroll
  for (int s = 0; s < 4; ++s) {
    bf16x8 a = *(const bf16x8*)(Au + (th * 32 + l31) * 72 + s * 16 + hh * 8);
#pragma unroll
    for (int m = 0; m < 4; ++m) {
      bf16x8 bb = *(const bf16x8*)(Wl + (size_t)(m * 64 + chh * 32 + l31) * 64 + s * 16 + hh * 8);
      acc[m] = MFMA32(a, bb, acc[m]);
    }
  }
  asm volatile("s_nop 15\n\ts_nop 15" ::: "memory");
  const int cl = chh * 32 + l31, cg = g * 64 + cl;
  float hsum[16];
#pragma unroll
  for (int dir = 0; dir < 2; ++dir) {
    const float ba = p->lru_ba[(l * 2 + dir) * 512 + cg], bx = p->lru_bx[(l * 2 + dir) * 512 + cg];
    const float lam = p->lru_lam[(l * 2 + dir) * 512 + cg];
    const float ex = __expf(-lam);
    const float sp = (ex < 0.03f) ? ex * (1.f - ex * (0.5f - ex * (0.33333334f - 0.25f * ex))) : __logf(1.f + ex);
#pragma unroll
    for (int r = 0; r < 16; ++r) {
      const int t = th * 32 + crow(r, hh);
      const float rg = sigmoidf_(acc[dir * 2][r] + ba), ig = sigmoidf_(acc[dir * 2 + 1][r] + bx);
      const float la = -8.f * rg * sp;
      const float a = __expf(la);
      const float z2 = 2.f * la;
      const float em = (z2 > -0.2f) ? -z2 * (1.f + z2 * (0.5f + z2 * (0.16666667f + z2 * (0.041666668f + z2 * 0.0083333338f)))) : 1.f - __expf(z2);
      const float gain = sqrtf(em);
      sa[cl * 65 + t] = a;
      sb[cl * 65 + t] = gain * ig * uf[t * 65 + cl];
    }
    __syncthreads();
    if (tid < 64) {
      const int c = tid;
      float h = 0.f, A = 1.f;
      if (pass == 3) { const f32x2 c0 = ((const f32x2*)carry)[(0 * 2 + dir) * 64 + c], c1 = ((const f32x2*)carry)[(1 * 2 + dir) * 64 + c]; h = c1.x * c0.y + c1.y; }
      if (dir == 0) {
#pragma unroll 8
        for (int t = 0; t < 64; ++t) { float a = sa[c * 65 + t]; h = a * h + sb[c * 65 + t]; A *= a; sb[c * 65 + t] = h; }
      } else {
#pragma unroll 8
        for (int t = 63; t >= 0; --t) { float a = sa[c * 65 + t]; h = a * h + sb[c * 65 + t]; A *= a; sb[c * 65 + t] = h; }
      }
      if (pass == 1) agg[((size_t)(b * 68 + j) * 2 + dir) * 512 + g * 64 + c] = mkf2(A, h);
    }
    __syncthreads();
    if (pass == 3) {
#pragma unroll
      for (int r = 0; r < 16; ++r) {
        const int t = th * 32 + crow(r, hh);
        float hv = sb[cl * 65 + t];
        hsum[r] = dir ? (hsum[r] + hv) : hv;
      }
    }
    __syncthreads();
  }
  if (pass == 3) {
    u16* Zlg = (u16*)(p->ws + OFF_ZLG);
#pragma unroll
    for (int r = 0; r < 16; ++r) {
      const int t = th * 32 + crow(r, hh);
      const size_t idx = (size_t)(base + t) * 512 + cg;
      const u16 ov = f2bf(hsum[r] * gelu_tanh(bf2f(Zlg[idx])));
      if (dummy) ((u16*)(p->ws + OFF_END))[(size_t)((base + t) & 2047) * 512 + cg] = ov; else Zlg[idx] = ov;
    }
  }
}

DI void attn_unit(KP p, int u, char* smem, int dummy = 0) {
  int b, hd, qrow0, nkt;
  if (u < 512) { b = u >> 7; hd = (u >> 4) & 7; qrow0 = b * 4096 + (u & 15) * 256; nkt = 68; }
  else { int uu = u - 512; b = uu >> 3; hd = uu & 7; qrow0 = MLAT + b * 256; nkt = 4; }
  const int tid = tidx(), lane = tid & 63, w = tid >> 6, l31 = lane & 31, hh = lane >> 5;
  u16* Ks = (u16*)smem;
  u16* Vs = Ks + 64 * 104;
  u16* Q = (u16*)(p->ws + OFF_Q);
  const u16* Kg = (const u16*)(p->ws + OFF_K) + (size_t)(b * 8 + hd) * NKEY * 96;
  const u16* Vg = (const u16*)(p->ws + OFF_VT) + (size_t)(b * 8 + hd) * 64 * NKEY;
  const int qrow = qrow0 + w * 64 + l31;
  bf16x8 qf[2][6];
#pragma unroll
  for (int g = 0; g < 2; ++g)
#pragma unroll
    for (int s = 0; s < 6; ++s) qf[g][s] = *(const bf16x8*)(Q + (size_t)(qrow + 32 * g) * 768 + hd * 96 + s * 16 + hh * 8);
  f32x16 O[2][2];
#pragma unroll
  for (int g = 0; g < 2; ++g) { zero_acc(O[g][0]); zero_acc(O[g][1]); }
  float mrun[2] = {-1e30f, -1e30f}, lsum[2] = {0.f, 0.f};
  const float scl = 0.10206207261596577f * 1.4426950408889634f;
  u32x4 rk[3], rv[2];
  auto loadt = [&](int kt) {
#pragma unroll
    for (int i = 0; i < 3; ++i) {
      int c = tid + 256 * i, key = c / 12, part = c % 12;
      rk[i] = *(const u32x4*)(Kg + (size_t)(kt * 64 + key) * 96 + part * 8);
    }
#pragma unroll
    for (int i = 0; i < 2; ++i) {
      int c = tid + 256 * i, dv = c >> 3, part = c & 7;
      rv[i] = *(const u32x4*)(Vg + (size_t)dv * NKEY + kt * 64 + part * 8);
    }
  };
  loadt(0);
  for (int kt = 0; kt < nkt; ++kt) {
    __syncthreads();
#pragma unroll
    for (int i = 0; i < 3; ++i) {
      int c = tid + 256 * i, key = c / 12, part = c % 12;
      *(u32x4*)(Ks + key * 104 + part * 8) = rk[i];
    }
#pragma unroll
    for (int i = 0; i < 2; ++i) {
      int c = tid + 256 * i, dv = c >> 3, part = c & 7;
      *(u32x2*)(Vs + dv * 68 + part * 8) = mk2(rv[i].x, rv[i].y);
      *(u32x2*)(Vs + dv * 68 + part * 8 + 4) = mk2(rv[i].z, rv[i].w);
    }
    __syncthreads();
    if (kt + 1 < nkt) loadt(kt + 1);
    f32x16 S[2][2];
#pragma unroll
    for (int g = 0; g < 2; ++g) { zero_acc(S[g][0]); zero_acc(S[g][1]); }
#pragma unroll
    for (int mt = 0; mt < 2; ++mt)
#pragma unroll
      for (int s = 0; s < 6; ++s) {
        const bf16x8 a = *(const bf16x8*)(Ks + (mt * 32 + l31) * 104 + s * 16 + hh * 8);
        S[0][mt] = MFMA32(a, qf[0][s], S[0][mt]);
        S[1][mt] = MFMA32(a, qf[1][s], S[1][mt]);
      }
    asm volatile("s_nop 15\n\ts_nop 15" ::: "memory");
#pragma unroll
    for (int g = 0; g < 2; ++g) {
      float mx = -1e30f;
#pragma unroll
      for (int mt = 0; mt < 2; ++mt)
#pragma unroll
        for (int r = 0; r < 16; ++r) mx = fmaxf(mx, S[g][mt][r]);
      mx = fmaxf(mx, __shfl_xor(mx, 32)) * scl;
      const float mnew = fmaxf(mrun[g], mx);
      const float alpha = __builtin_amdgcn_exp2f(mrun[g] - mnew);
      mrun[g] = mnew;
      float ps = 0.f;
#pragma unroll
      for (int mt = 0; mt < 2; ++mt)
#pragma unroll
        for (int r = 0; r < 16; ++r) { float e = __builtin_amdgcn_exp2f(fmaf(S[g][mt][r], scl, -mnew)); S[g][mt][r] = e; ps += e; }
      lsum[g] = lsum[g] * alpha + ps;
      if (__builtin_amdgcn_ballot_w64(alpha != 1.f) != 0ull) {
#pragma unroll
        for (int d = 0; d < 2; ++d)
#pragma unroll
          for (int r = 0; r < 16; ++r) O[g][d][r] *= alpha;
      }
    }
#pragma unroll
    for (int mt = 0; mt < 2; ++mt)
#pragma unroll
      for (int s2 = 0; s2 < 2; ++s2) {
        bf16x8 pf[2];
#pragma unroll
        for (int g = 0; g < 2; ++g) {
          unsigned pk[4];
#pragma unroll
          for (int q = 0; q < 4; ++q) pk[q] = pack2(S[g][mt][8 * s2 + 2 * q], S[g][mt][8 * s2 + 2 * q + 1]);
          pf[g] = __builtin_bit_cast(bf16x8, (u32x4{pk[0], pk[1], pk[2], pk[3]}));
        }
#pragma unroll
        for (int d = 0; d < 2; ++d) {
          const u16* vp = Vs + (d * 32 + l31) * 68 + mt * 32 + s2 * 16 + 4 * hh;
          u32x2 lo = *(const u32x2*)vp, hi = *(const u32x2*)(vp + 8);
          const bf16x8 va = __builtin_bit_cast(bf16x8, (u32x4{lo.x, lo.y, hi.x, hi.y}));
          O[0][d] = MFMA32(va, pf[0], O[0][d]);
          O[1][d] = MFMA32(va, pf[1], O[1][d]);
        }
      }
    asm volatile("s_nop 15\n\ts_nop 15" ::: "memory");
  }
#pragma unroll
  for (int g = 0; g < 2; ++g) {
    const float lt = lsum[g] + __shfl_xor(lsum[g], 32);
    const float inv = 1.f / lt;
    u16* dst = Q + (size_t)(qrow + 32 * g) * 768 + hd * 96;
    if (dummy) dst = (u16*)(p->ws + OFF_END) + (size_t)((qrow + 32 * g) & 1023) * 768 + hd * 96;
#pragma unroll
    for (int d = 0; d < 2; ++d)
#pragma unroll
      for (int q = 0; q < 4; ++q)
        *(u32x2*)(dst + d * 32 + 8 * q + 4 * hh) =
            mk2(pack2(O[g][d][4 * q] * inv, O[g][d][4 * q + 1] * inv), pack2(O[g][d][4 * q + 2] * inv, O[g][d][4 * q + 3] * inv));
  }
}

DI f32x2 cmul(f32x2 a, f32x2 b) { return mkf2(a.x * b.x - a.y * b.y, a.x * b.y + a.y * b.x); }
#define SW(x) ((x) ^ ((((x) >> 5) & 1) * 5) ^ ((((x) >> 6) & 1) * 26))
DI void fft8192(f32x2* buf, const f32x2* __restrict__ tw) {
  const int tid = tidx();
#pragma unroll 1
  for (int ls = 0; ls < 12; ls += 2) {
    const int s = 1 << ls;
    f32x2 a[8], b[8], c[8], d[8];
    __syncthreads();
#pragma unroll
    for (int e = 0; e < 8; ++e) {
      const int i = tid + 256 * e;
      const int pi = SW(i);
      a[e] = buf[pi]; b[e] = buf[pi + 2048]; c[e] = buf[pi + 4096]; d[e] = buf[pi + 6144];
    }
    __syncthreads();
#pragma unroll
    for (int e = 0; e < 8; ++e) {
      const int i = tid + 256 * e;
      const int q = i & (s - 1);
      const int ps = i - q;
      const float rev = (float)ps * (1.f / 8192.f);
      const f32x2 w1 = mkf2(__builtin_amdgcn_cosf(rev), -__builtin_amdgcn_sinf(rev));
      const f32x2 w2 = cmul(w1, w1), w3 = cmul(w1, w2);
      const f32x2 apc = mkf2(a[e].x + c[e].x, a[e].y + c[e].y), amc = mkf2(a[e].x - c[e].x, a[e].y - c[e].y);
      const f32x2 bpd = mkf2(b[e].x + d[e].x, b[e].y + d[e].y), bmd = mkf2(b[e].x - d[e].x, b[e].y - d[e].y);
      const int o = 4 * i - 3 * q;
      buf[SW(o)] = mkf2(apc.x + bpd.x, apc.y + bpd.y);
      buf[SW(o + s)] = cmul(w1, mkf2(amc.x + bmd.y, amc.y - bmd.x));
      buf[SW(o + 2 * s)] = cmul(w2, mkf2(apc.x - bpd.x, apc.y - bpd.y));
      buf[SW(o + 3 * s)] = cmul(w3, mkf2(amc.x - bmd.y, amc.y + bmd.x));
    }
  }
  {
    f32x2 a[16], b[16];
    __syncthreads();
#pragma unroll
    for (int e = 0; e < 16; ++e) { const int pi = SW(tid + 256 * e); a[e] = buf[pi]; b[e] = buf[pi + 4096]; }
    __syncthreads();
#pragma unroll
    for (int e = 0; e < 16; ++e) {
      const int pi = SW(tid + 256 * e);
      buf[pi] = mkf2(a[e].x + b[e].x, a[e].y + b[e].y);
      buf[pi + 4096] = mkf2(a[e].x - b[e].x, a[e].y - b[e].y);
    }
    __syncthreads();
  }
}
DI float sconv3(const u16* row, int t, int n, float w0, float w1, float w2, float bias) {
  float xm = (t > 0) ? bf2f(row[t - 1]) : 0.f, x0 = bf2f(row[t]), xp = (t + 1 < n) ? bf2f(row[t + 1]) : 0.f;
  return w0 * xm + w1 * x0 + w2 * xp + bias;
}
DI void hyena_unit(KP p, int l, int c, char* smem) {
  const int tid = tidx();
  f32x2* buf = (f32x2*)smem;
  const f32x2* tw = (const f32x2*)(p->ws + OFF_TW);
  const u16* Ff = (const u16*)(p->ws + OFF_FILT);
  const float* wout = p->hy_w_out + (size_t)l * 64 * 2048;
  const float mind = -4.605170185988091f / 1.5f, maxd = -4.605170185988091f / 0.3f;
  const float delta = fabsf(mind + (float)c * ((maxd - mind) / 511.f));
  u16* Zhy = (u16*)(p->ws + OFF_ZHY);
  u16* yct = (u16*)(p->ws + OFF_YCT);
  const float* cw = p->hy_conv_w + (size_t)l * 3 * 1536;
  const float* cb = p->hy_conv_b + (size_t)l * 1536;
  f32x2 KF[32];
#pragma unroll 1
  for (int o = 0; o < 2; ++o) {
    const int colf = o * 512 + c, colb = 1024 + o * 512 + c;
    const float skip = p->hy_skip[(l * 2 + o) * 512 + c];
    __syncthreads();
#pragma unroll 4
    for (int jj = 0; jj < 16; ++jj) {
      const int t = tid + 256 * jj;
      const float hf = bf2f(Ff[(size_t)colf * 4096 + t]), hb = bf2f(Ff[(size_t)colb * 4096 + t]);
      if (t == 0) { buf[SW(0)] = mkf2(hf + hb + skip, 0.f); buf[SW(4096)] = mkf2(0.f, 0.f); }
      else { buf[SW(t)] = mkf2(hf, 0.f); buf[SW(8192 - t)] = mkf2(hb, 0.f); }
    }
    fft8192(buf, tw);
#pragma unroll
    for (int j = 0; j < 32; ++j) KF[j] = buf[SW(tid + 256 * j)];
    const int gcol = (o == 0 ? 512 : 1024) + c;
    const float gw0 = cw[gcol], gw1 = cw[1536 + gcol], gw2 = cw[3072 + gcol], gb = cb[gcol];
    const float vw0 = cw[c], vw1 = cw[1536 + c], vw2 = cw[3072 + c], vb = cb[c];
#pragma unroll 1
    for (int pr = 0; pr < 2; ++pr) {
      const int b0 = 2 * pr, b1 = b0 + 1;
      u16* r0 = Zhy + (size_t)(b0 * 1536 + c) * 4096;
      u16* r1 = Zhy + (size_t)(b1 * 1536 + c) * 4096;
      u16* y0p = yct + (size_t)(b0 * 512 + c) * 4096;
      u16* y1p = yct + (size_t)(b1 * 512 + c) * 4096;
      __syncthreads();
#pragma unroll 4
      for (int jj = 0; jj < 16; ++jj) {
        const int t = tid + 256 * jj;
        float v0, v1;
        if (o == 0) { v0 = sconv3(r0, t, 4096, vw0, vw1, vw2, vb); v1 = sconv3(r1, t, 4096, vw0, vw1, vw2, vb); }
        else { v0 = bf2f(r0[t]); v1 = bf2f(r1[t]); }
        buf[SW(t)] = mkf2(v0, v1);
        buf[SW(t + 4096)] = mkf2(0.f, 0.f);
      }
      fft8192(buf, tw);
#pragma unroll
      for (int j = 0; j < 32; ++j) {
        const int f = tid + 256 * j;
        f32x2 z = cmul(buf[SW(f)], KF[j]);
        buf[SW(f)] = mkf2(z.x, -z.y);
      }
      fft8192(buf, tw);
      const u16* g0 = Zhy + (size_t)(b0 * 1536 + gcol) * 4096;
      const u16* g1 = Zhy + (size_t)(b1 * 1536 + gcol) * 4096;
#pragma unroll 4
      for (int jj = 0; jj < 16; ++jj) {
        const int t = tid + 256 * jj;
        const f32x2 r = buf[SW(t)];
        const float y0 = r.x * (1.f / 8192.f), y1 = -r.y * (1.f / 8192.f);
        const float x0 = sconv3(g0, t, 4096, gw0, gw1, gw2, gb), x1 = sconv3(g1, t, 4096, gw0, gw1, gw2, gb);
        if (o == 0) { r0[t] = f2bf(x0 * y0); r1[t] = f2bf(x1 * y1); }
        else { y0p[t] = f2bf(x0 * y0); y1p[t] = f2bf(x1 * y1); }
      }
    }
  }
  if (l == 0) {
    float* kk = (float*)smem;
    float* uu = kk + 512;
    const float* hid2 = (const float*)(p->ws + OFF_HID256);
    const u16* Zhc = (const u16*)(p->ws + OFF_ZHC);
    const int t = tid;
    float y1r[4];
#pragma unroll 1
    for (int o = 0; o < 2; ++o) {
      const int colf = o * 512 + c, colb = 1024 + o * 512 + c;
      const float skip = p->hy_skip[(l * 2 + o) * 512 + c];
      const int gcol = (o == 0 ? 512 : 1024) + c;
      const float gw0 = cw[gcol], gw1 = cw[1536 + gcol], gw2 = cw[3072 + gcol], gb = cb[gcol];
      const float vw0 = cw[c], vw1 = cw[1536 + c], vw2 = cw[3072 + c], vb = cb[c];
      __syncthreads();
      {
        float hf = 0.f, hb = 0.f;
        const f32x4* hr = (const f32x4*)(hid2 + t * 64);
#pragma unroll
        for (int j4 = 0; j4 < 16; ++j4) {
          const f32x4 hv = hr[j4];
          const float* wf = wout + (size_t)(4 * j4) * 2048;
          hf += hv.x * wf[colf] + hv.y * wf[2048 + colf] + hv.z * wf[4096 + colf] + hv.w * wf[6144 + colf];
          hb += hv.x * wf[colb] + hv.y * wf[2048 + colb] + hv.z * wf[4096 + colb] + hv.w * wf[6144 + colb];
        }
        const float dec = expf(-((float)t / 255.f) * delta);
        hf *= dec; hb *= dec;
        if (t == 0) kk[255] = hf + hb + skip;
        else { kk[255 + t] = hf; kk[255 - t] = hb; }
        if (t == 0) kk[511] = 0.f;
        f32x4 uv;
        if (o == 0) {
          uv.x = sconv3(Zhc + (size_t)(0 * 1536 + c) * 256, t, 256, vw0, vw1, vw2, vb);
          uv.y = sconv3(Zhc + (size_t)(1 * 1536 + c) * 256, t, 256, vw0, vw1, vw2, vb);
          uv.z = sconv3(Zhc + (size_t)(2 * 1536 + c) * 256, t, 256, vw0, vw1, vw2, vb);
          uv.w = sconv3(Zhc + (size_t)(3 * 1536 + c) * 256, t, 256, vw0, vw1, vw2, vb);
        } else uv = mkf4(y1r[0], y1r[1], y1r[2], y1r[3]);
        ((f32x4*)uu)[t] = uv;
      }
      __syncthreads();
      {
        f32x4 y = mkf4(0.f, 0.f, 0.f, 0.f);
#pragma unroll 8
        for (int s2 = 0; s2 < 256; ++s2) { const float kv = kk[255 + t - s2]; const f32x4 u4 = ((const f32x4*)uu)[s2]; y += kv * u4; }
        const f32x4 ut = ((const f32x4*)uu)[t];
        const float yy[4] = {y.x, y.y, y.z, y.w}, us[4] = {ut.x, ut.y, ut.z, ut.w};
#pragma unroll
        for (int b = 0; b < 4; ++b) {
          const float xg = sconv3(Zhc + (size_t)(b * 1536 + gcol) * 256, t, 256, gw0, gw1, gw2, gb);
          const float ov = xg * yy[b];
          if (o == 0) y1r[b] = ov;
          else yct[(size_t)NB * 512 * 4096 + (size_t)(b * 512 + c) * 256 + t] = f2bf(ov);
        }
      }
    }
  }
}


DI void yc_transpose_unit(KP p, int u, char* smem) {
  const int tid = tidx();
  const u16* src; u16* dst; int rowlen;
  int b, cb, tb;
  if (u < 2048) { b = u >> 9; cb = (u >> 6) & 7; tb = u & 63; rowlen = 4096;
    src = (const u16*)(p->ws + OFF_YCT) + (size_t)(b * 512 + cb * 64) * 4096 + tb * 64;
    dst = (u16*)(p->ws + OFF_YC) + (size_t)(b * 4096 + tb * 64) * 512 + cb * 64; }
  else { const int uu = u - 2048; b = uu >> 5; cb = (uu >> 2) & 7; tb = uu & 3; rowlen = 256;
    src = (const u16*)(p->ws + OFF_YCT) + (size_t)NB * 512 * 4096 + (size_t)(b * 512 + cb * 64) * 256 + tb * 64;
    dst = (u16*)(p->ws + OFF_YC) + (size_t)(MLAT + b * 256 + tb * 64) * 512 + cb * 64; }
  u16* tile = (u16*)smem;
  const int r = tid >> 2, q = tid & 3;
  __syncthreads();
  {
    const u32x4 v0 = *(const u32x4*)(src + (size_t)r * rowlen + q * 16);
    const u32x4 v1 = *(const u32x4*)(src + (size_t)r * rowlen + q * 16 + 8);
    unsigned* tp = (unsigned*)(tile + r * 66 + q * 16);
    tp[0] = v0.x; tp[1] = v0.y; tp[2] = v0.z; tp[3] = v0.w; tp[4] = v1.x; tp[5] = v1.y; tp[6] = v1.z; tp[7] = v1.w;
  }
  __syncthreads();
  {
    unsigned o[8];
#pragma unroll
    for (int e = 0; e < 8; ++e)
      o[e] = (unsigned)tile[(q * 16 + 2 * e) * 66 + r] | ((unsigned)tile[(q * 16 + 2 * e + 1) * 66 + r] << 16);
    u16* d = dst + (size_t)r * 512 + q * 16;
    *(u32x4*)d = u32x4{o[0], o[1], o[2], o[3]};
    *(u32x4*)(d + 8) = u32x4{o[4], o[5], o[6], o[7]};
  }
}

DI void p5_merge(KP p, int u, int mtiles, char* smem) {
  int mt, nt; tile_map(u, mtiles, 8, mt, nt);
  const int lane = tidx() & 63, w = tidx() >> 6, wm = w >> 1, wn = w & 1, l31 = lane & 31, hh = lane >> 5;
  const u16* W = (const u16*)(p->ws + OFF_W);
  const u16* H = (const u16*)(p->ws + OFF_H) + (size_t)mt * 128 * 1024;
  f32x16 out[2][2];
#pragma unroll
  for (int i = 0; i < 2; ++i)
#pragma unroll
    for (int j = 0; j < 2; ++j) zero_acc(out[i][j]);
#pragma unroll 1
  for (int br = 0; br < 3; ++br) {
    f32x16 acc[2][2];
#pragma unroll
    for (int i = 0; i < 2; ++i)
#pragma unroll
      for (int j = 0; j < 2; ++j) zero_acc(acc[i][j]);
    gemm_main_np<2>(acc, H, 1024, 0, W + W_ING + (size_t)(br * 1024 + nt * 128) * 1024, 1024, 1024, smem);
    unsigned gp[2][2][8];
#pragma unroll
    for (int i = 0; i < 2; ++i)
#pragma unroll
      for (int j = 0; j < 2; ++j)
#pragma unroll
        for (int q = 0; q < 8; ++q) {
          gp[i][j][q] = pack2(sigmoidf_(acc[i][j][2 * q]), sigmoidf_(acc[i][j][2 * q + 1]));
          acc[i][j][2 * q] = 0.f; acc[i][j][2 * q + 1] = 0.f;
        }
    const u16* A;
    int lda, amode = 0;
    if (br == 0) { A = (const u16*)(p->ws + OFF_Q) + (size_t)mt * 128 * 768; lda = 768; amode = 1; }
    else if (br == 1) { A = (const u16*)(p->ws + OFF_ZLG) + (size_t)mt * 128 * 512; lda = 512; }
    else { A = (const u16*)(p->ws + OFF_YC) + (size_t)mt * 128 * 512; lda = 512; }
    gemm_main_np<2>(acc, A, lda, amode, W + W_BRA + (size_t)br * 1024 * 512 + (size_t)nt * 128 * 512, 512, 512, smem);
#pragma unroll
    for (int i = 0; i < 2; ++i)
#pragma unroll
      for (int j = 0; j < 2; ++j)
#pragma unroll
        for (int q = 0; q < 8; ++q) {
          out[i][j][2 * q] += __uint_as_float(gp[i][j][q] << 16) * acc[i][j][2 * q];
          out[i][j][2 * q + 1] += __uint_as_float(gp[i][j][q] & 0xffff0000u) * acc[i][j][2 * q + 1];
        }
  }
  u16* YM = (u16*)(p->ws + OFF_YM);
#pragma unroll
  for (int i = 0; i < 2; ++i)
#pragma unroll
    for (int j = 0; j < 2; ++j) {
      const int mrow0 = mt * 128 + wm * 64 + i * 32, n0 = nt * 128 + wn * 64 + j * 32;
      store_tile_bf16(YM + (size_t)mrow0 * 1024 + n0, 1024, out[i][j], l31, hh);
    }
}


DI void p5_merge_half(KP p, int u, int mt_off, char* smem) {
  const int mt = mt_off + (u >> 4), nt = u & 15;
  const int lane = tidx() & 63, w = tidx() >> 6, wm = w >> 1, wn = w & 1, l31 = lane & 31, hh = lane >> 5;
  const u16* W = (const u16*)(p->ws + OFF_W);
  const u16* H = (const u16*)(p->ws + OFF_H) + (size_t)mt * 128 * 1024;
  f32x16 out[2][1];
  zero_acc(out[0][0]); zero_acc(out[1][0]);
#pragma unroll 1
  for (int br = 0; br < 3; ++br) {
    f32x16 ag[2][1], ay[2][1];
    zero_acc(ag[0][0]); zero_acc(ag[1][0]); zero_acc(ay[0][0]); zero_acc(ay[1][0]);
    gemm_main_np<1>(ag, H, 1024, 0, W + W_ING + (size_t)(br * 1024 + nt * 64) * 1024, 1024, 1024, smem);
    const u16* A;
    int lda, amode = 0;
    if (br == 0) { A = (const u16*)(p->ws + OFF_Q) + (size_t)mt * 128 * 768; lda = 768; amode = 1; }
    else if (br == 1) { A = (const u16*)(p->ws + OFF_ZLG) + (size_t)mt * 128 * 512; lda = 512; }
    else { A = (const u16*)(p->ws + OFF_YC) + (size_t)mt * 128 * 512; lda = 512; }
    gemm_main_np<1>(ay, A, lda, amode, W + W_BRA + (size_t)br * 1024 * 512 + (size_t)nt * 64 * 512, 512, 512, smem);
#pragma unroll
    for (int i = 0; i < 2; ++i)
#pragma unroll
      for (int r = 0; r < 16; ++r) out[i][0][r] += sigmoidf_(ag[i][0][r]) * ay[i][0][r];
  }
  u16* YM = (u16*)(p->ws + OFF_YM);
#pragma unroll
  for (int i = 0; i < 2; ++i) {
    const int mrow0 = mt * 128 + wm * 64 + i * 32, n0 = nt * 64 + wn * 32;
    store_tile_bf16(YM + (size_t)mrow0 * 1024 + n0, 1024, out[i][0], l31, hh);
  }
}

DI void resid_gemm(KP p, int l, int u, int mtiles, int which, const u16* A, int K, const u16* Wt, const float* xlat_in,
                   const float* xctx_in, float* xlat_out, float* xctx_out, char* smem, int dummy = 0, int mt_off = 0) {
  int mt, nt; tile_map(u, mtiles, 8, mt, nt); mt += mt_off;
  const int lane = tidx() & 63, w = tidx() >> 6, wm = w >> 1, wn = w & 1, l31 = lane & 31, hh = lane >> 5;
  f32x16 acc[2][2];
#pragma unroll
  for (int i = 0; i < 2; ++i)
#pragma unroll
    for (int j = 0; j < 2; ++j) zero_acc(acc[i][j]);
  gemm_main<2>(acc, A + (size_t)mt * 128 * K, K, 0, Wt + (size_t)nt * 128 * K, K, K, smem);
  int b, t0, isctx;
  rowinfo(mt * 128, b, t0, isctx);
  const float* gate = (const float*)(p->ws + OFF_MODS) + (size_t)(l * 5 + (isctx ? 4 : b)) * 6144 + which * 3072 + 2048;
#pragma unroll
  for (int i = 0; i < 2; ++i)
#pragma unroll
    for (int j = 0; j < 2; ++j) {
      const int mrow0 = mt * 128 + wm * 64 + i * 32, n = nt * 128 + wn * 64 + j * 32 + l31;
      const float gv = gate[n];
#pragma unroll
      for (int r = 0; r < 16; ++r) {
        const int row = mrow0 + crow(r, hh);
        if (dummy) ((float*)(p->ws + OFF_H))[(size_t)(row & 8191) * 1024 + n] = xlat_in[(size_t)(row & 8191) * 1024 + n] + gv * acc[i][j][r];
        else if (!isctx) xlat_out[(size_t)row * 1024 + n] = xlat_in[(size_t)row * 1024 + n] + gv * acc[i][j][r];
        else { size_t o = (size_t)(row - MLAT) * 1024 + n; xctx_out[o] = xctx_in[o] + gv * acc[i][j][r]; }
      }
    }
}


DI void resid_wide(KP p, int l, int u, int which, const u16* A, int K, const u16* Wt, const float* xin, float* xout, char* smem) {
  int mt, nt; tile_map(u, 128, 4, mt, nt);
  const int lane = tidx() & 63, w = tidx() >> 6, wm = w >> 1, wn = w & 1, l31 = lane & 31, hh = lane >> 5;
  f32x16 acc[2][4];
#pragma unroll
  for (int i = 0; i < 2; ++i)
#pragma unroll
    for (int j = 0; j < 4; ++j) zero_acc(acc[i][j]);
  gemm_wide(acc, A + (size_t)mt * 128 * K, K, Wt + (size_t)nt * 256 * K, K, K, smem);
  const int b = (mt * 128) >> 12;
  const float* gate = (const float*)(p->ws + OFF_MODS) + (size_t)(l * 5 + b) * 6144 + which * 3072 + 2048;
#pragma unroll
  for (int i = 0; i < 2; ++i)
#pragma unroll
    for (int j = 0; j < 4; ++j) {
      const int mrow0 = mt * 128 + wm * 64 + i * 32, n = nt * 256 + wn * 128 + j * 32 + l31;
      const float gv = gate[n];
#pragma unroll
      for (int r = 0; r < 16; ++r) {
        const size_t o = (size_t)(mrow0 + crow(r, hh)) * 1024 + n;
        xout[o] = xin[o] + gv * acc[i][j][r];
      }
    }
}


DI void resid_ctx_half(KP p, int l, int u, int which, const u16* A, int K, const u16* Wt, const float* xin, float* xout, char* smem) {
  const int mt = 128 + (u >> 4), nt = u & 15;
  const int lane = tidx() & 63, w = tidx() >> 6, wm = w >> 1, wn = w & 1, l31 = lane & 31, hh = lane >> 5;
  f32x16 acc[2][1];
  zero_acc(acc[0][0]); zero_acc(acc[1][0]);
  gemm_main_np<1>(acc, A + (size_t)mt * 128 * K, K, 0, Wt + (size_t)nt * 64 * K, K, K, smem);
  const float* gate = (const float*)(p->ws + OFF_MODS) + (size_t)(l * 5 + 4) * 6144 + which * 3072 + 2048;
#pragma unroll
  for (int i = 0; i < 2; ++i) {
    const int mrow0 = (mt - 128) * 128 + wm * 64 + i * 32, n = nt * 64 + wn * 32 + l31;
    const float gv = gate[n];
#pragma unroll
    for (int r = 0; r < 16; ++r) {
      const size_t o = (size_t)(mrow0 + crow(r, hh)) * 1024 + n;
      xout[o] = xin[o] + gv * acc[i][0][r];
    }
  }
}

DI void p8_ffn_gu(KP p, int u, int mtiles, char* smem) {
  int mt, nt; tile_map(u, mtiles, 22, mt, nt, PANEL_W);
  const int lane = tidx() & 63, w = tidx() >> 6, wm = w >> 1, wn = w & 1, l31 = lane & 31, hh = lane >> 5;
  f32x16 acc[2][4];
#pragma unroll
  for (int i = 0; i < 2; ++i)
#pragma unroll
    for (int j = 0; j < 4; ++j) zero_acc(acc[i][j]);
  const u16* H = (const u16*)(p->ws + OFF_H);
  const u16* W = (const u16*)(p->ws + OFF_W) + W_GU;
  gemm_wide(acc, H + (size_t)mt * 128 * 1024, 1024, W + (size_t)nt * 256 * 1024, 1024, 1024, smem);
  u16* act = (u16*)(p->ws + OFF_ACT);
#pragma unroll
  for (int i = 0; i < 2; ++i)
#pragma unroll
    for (int jp = 0; jp < 2; ++jp) {
      const int mrow0 = mt * 128 + wm * 64 + i * 32, uu0 = (nt * 2 + wn) * 64 + jp * 32;
      f32x16 tv;
#pragma unroll
      for (int r = 0; r < 16; ++r) {
        const float gt = acc[i][2 * jp][r], up = acc[i][2 * jp + 1][r];
        tv[r] = gt * __builtin_amdgcn_rcpf(1.f + __expf(-gt)) * up;
      }
      store_tile_bf16(act + (size_t)mrow0 * FFN + uu0, FFN, tv, l31, hh);
    }
}


DI void p8_ffn_gu_half(KP p, int hu, char* smem) {
  int mt, ntw; tile_map(2560 + (hu >> 1), 128, 22, mt, ntw, PANEL_W);
  const int nt = ntw * 2 + (hu & 1);
  const int lane = tidx() & 63, w = tidx() >> 6, wm = w >> 1, wn = w & 1, l31 = lane & 31, hh = lane >> 5;
  f32x16 acc[2][2];
#pragma unroll
  for (int i = 0; i < 2; ++i)
#pragma unroll
    for (int j = 0; j < 2; ++j) zero_acc(acc[i][j]);
  const u16* H = (const u16*)(p->ws + OFF_H);
  const u16* W = (const u16*)(p->ws + OFF_W) + W_GU;
  gemm_main_np<2>(acc, H + (size_t)mt * 128 * 1024, 1024, 0, W + (size_t)nt * 128 * 1024, 1024, 1024, smem);
  u16* act = (u16*)(p->ws + OFF_ACT);
#pragma unroll
  for (int i = 0; i < 2; ++i) {
    const int mrow0 = mt * 128 + wm * 64 + i * 32, uu0 = nt * 64 + wn * 32;
    f32x16 tv;
#pragma unroll
    for (int r = 0; r < 16; ++r) {
      const float gt = acc[i][0][r], up = acc[i][1][r];
      tv[r] = gt * __builtin_amdgcn_rcpf(1.f + __expf(-gt)) * up;
    }
    store_tile_bf16(act + (size_t)mrow0 * FFN + uu0, FFN, tv, l31, hh);
  }
}

DI void final_norm(KP p, int u) {
  const int lane = tidx() & 63, w = tidx() >> 6;
  const int row = u * 4 + w;
  float* xr = p->out + (size_t)row * 1024;
  f32x4 v[4];
  float ss = 0;
#pragma unroll
  for (int j = 0; j < 4; ++j) {
    v[j] = *(const f32x4*)(xr + 4 * (lane + 64 * j));
    ss += v[j].x * v[j].x + v[j].y * v[j].y + v[j].z * v[j].z + v[j].w * v[j].w;
  }
  ss = wave_sum(ss);
  const float rstd = rsqrtf(ss * (1.f / 1024.f) + EPS);
#pragma unroll
  for (int j = 0; j < 4; ++j) {
    const int c0 = 4 * (lane + 64 * j);
    f32x4 gg = *(const f32x4*)(p->final_norm_g + c0);
    *(f32x4*)(xr + c0) = mkf4(v[j].x * rstd * gg.x, v[j].y * rstd * gg.y, v[j].z * rstd * gg.z, v[j].w * rstd * gg.w);
  }
}

__global__ void __launch_bounds__(256, 2) trunk_megakernel(Params pk) {
#define XC ((float*)(lp(p)->ws + OFF_XC))
#define xlat_in (l ? (const float*)lp(p)->out : lp(p)->x)
#define xctx_in (l ? (const float*)XC : lp(p)->ctx)
#define mtiles (l ? 128 : 136)
#define mrows (mtiles * 128)
  const KP p = (KP)__builtin_amdgcn_kernarg_segment_ptr();
  __shared__ __attribute__((aligned(16))) char smem[74240];
  __shared__ u32x4 xb_words;
  if (tidx() == 0) xb_words = u32x4{0u, 0u, 0u, 0u};
  __syncthreads();
  (void)xcd_barrier_post((unsigned*)(p->ws + OFF_BAR), (volatile LAS unsigned*)&xb_words);
#define GBAR() { XcdBarrier xb_; xb_.bar = (unsigned*)(lp(p)->ws + OFF_BAR); xb_.x = xb_xcc_id(); xb_.st = (volatile LAS unsigned*)&xb_words; xcd_barrier(xb_); }
  const int G = gridDim.x, B = blockIdx.x;

  for (int rep = 0; rep < REP_P0; ++rep)
  for (int u = B; u < 384 + 2112; u += G) {
    if (u < 384) p0_mods(lp(p), u, smem);
    else p0_hid(lp(p), u - 384, smem);
  }
  GBAR();

#pragma unroll 1
  for (int l = 0; l < 2; ++l) {

    for (int rep = 0; rep < REP_P1; ++rep)
    for (int u = B; u < MALL / 4 + CV1_UNITS + 1024; u += G) {
      if (u < MALL / 4) norm_rows(lp(p), l, 0, u, xlat_in, xctx_in);
      else if (u < MALL / 4 + CV1_UNITS) conv_stage1(lp(p), l, u - MALL / 4, smem);
      else filt_unit(lp(p), l, u - MALL / 4 - CV1_UNITS);
    }
    GBAR();
    for (int rep = 0; rep < REP_P2; ++rep)
    for (int u = B; u < 1536 + 464; u += G) {
      if (u < 1536) p2_inproj(lp(p), u, smem);
      else p2_inproj_half(lp(p), u - 1536, smem);
    }
    GBAR();
    for (int rep = 0; rep < REP_P3; ++rep)
    for (int u = B; u < 816 + 1088 + 2176 + 2176; u += G) {
      if (u < 816) p3_qproj(lp(p), u, smem);
      else if (u < 1904) p3_kvproj(lp(p), u - 816, smem);
      else if (u < 4080) p3_kpe(lp(p), u - 1904);
      else lru_unit(lp(p), l, u - 4080, 1, smem);
    }
    GBAR();
    {
      const int nattn = l ? 512 : 544;
      for (int rep = 1; rep < REP_HY; ++rep)
        for (int u = B; u < 512; u += G) hyena_unit(lp(p), l, u, smem);
      for (int rep = 1; rep < REP_AT; ++rep)
        for (int u = B; u < nattn; u += G) attn_unit(lp(p), u, smem, 1);
      for (int u = B; u < 512; u += G) hyena_unit(lp(p), l, u, smem);
      for (int u = B; u < nattn; u += G) attn_unit(lp(p), u, smem);
    }
    GBAR();
    for (int rep = 0; rep < REP_L3; ++rep)
      for (int u = B; u < 2176 + (l ? 2048 : 2176); u += G) {
        if (u < 2176) lru_unit(lp(p), l, u, 3, smem, rep + 1 < REP_L3);
        else yc_transpose_unit(lp(p), u - 2176, smem);
      }
    for (int rep = 1; rep < REP_SY; ++rep) GBAR();
    GBAR();
    for (int u = B; u < 1024 + (l ? 0 : 128); u += G) {
      if (u < 1024) p5_merge(lp(p), u, 128, smem);
      else p5_merge_half(lp(p), u - 1024, 128, smem);
    }
    GBAR();
    for (int u = B; u < 512 + (l ? 0 : 128); u += G) {
      if (u < 512) resid_wide(lp(p), l, u, 0, (const u16*)(p->ws + OFF_YM), 1024, (const u16*)(p->ws + OFF_W) + W_OUT, xlat_in, p->out, smem);
      else resid_ctx_half(lp(p), l, u - 512, 0, (const u16*)(p->ws + OFF_YM), 1024, (const u16*)(p->ws + OFF_W) + W_OUT, xctx_in, XC, smem);
    }
    GBAR();
    for (int rep = 0; rep < REP_P7; ++rep)
    for (int u = B; u < mrows / 4 + CV2_UNITS; u += G) {
      if (u < mrows / 4) norm_rows(lp(p), l, 1, u, p->out, XC);
      else conv_stage2(lp(p), l, u - mrows / 4, smem);
    }
    GBAR();
    if (l == 0) { for (int u = B; u < 136 * 22; u += G) p8_ffn_gu(lp(p), u, 136, smem); }
    else {
      for (int u = B; u < 2560 + 512; u += G) {
        if (u < 2560) p8_ffn_gu(lp(p), u, 128, smem);
        else p8_ffn_gu_half(lp(p), u - 2560, smem);
      }
    }
    GBAR();
    for (int u = B; u < 512 + (l ? 0 : 128); u += G) {
      if (u < 512) resid_wide(lp(p), l, u, 1, (const u16*)(p->ws + OFF_ACT), FFN, (const u16*)(p->ws + OFF_W) + W_DN, p->out, p->out, smem);
      else resid_ctx_half(lp(p), l, u - 512, 1, (const u16*)(p->ws + OFF_ACT), FFN, (const u16*)(p->ws + OFF_W) + W_DN, XC, XC, smem);
    }
    GBAR();
  }
  for (int u = B; u < MLAT / 4; u += G) final_norm(lp(p), u);
}
#undef XC
#undef xlat_in
#undef xctx_in
#undef mtiles
#undef mrows

extern "C" void kernel_launch(void* const* d_in, const int* in_sizes, int n_in, void* d_out, int out_size, void* d_ws,
                              size_t ws_size, hipStream_t stream) {
  static int grid_blocks = 0;
  if (!grid_blocks) {
    int dev = 0, cus = 0, per_cu = 0;
    hipGetDevice(&dev);
    hipDeviceGetAttribute(&cus, hipDeviceAttributeMultiprocessorCount, dev);
    hipOccupancyMaxActiveBlocksPerMultiprocessor(&per_cu, trunk_megakernel, 256, 0);
    if (per_cu > 2) per_cu = 2;
    if (per_cu < 1) per_cu = 1;
    grid_blocks = cus * per_cu;
  }
  Params p{};
  const float** pp = (const float**)&p;
  for (int i = 0; i < 37; ++i) pp[i] = (const float*)d_in[i];
  p.out = (float*)d_out;
  p.ws = (char*)d_ws;
  if (ws_size < OFF_END) fprintf(stderr, "workspace too small: %zu < %zu\n", ws_size, (size_t)OFF_END);
  hipMemsetAsync((char*)d_ws + OFF_BAR, 0, 16384, stream);
  void* args[] = {&p};
  hipError_t e = hipLaunchCooperativeKernel((void*)trunk_megakernel, dim3(grid_blocks), dim3(256), args, 0, stream);
  if (e != hipSuccess) fprintf(stderr, "cooperative launch failed: %s (grid %d)\n", hipGetErrorString(e), grid_blocks);
}
```
